# Optimizing an MI355X kernel written in HIP

```python
import math
import jax, jax.numpy as jnp
from jax import lax
import numpy as np

D_MODEL = 2048
BATCH = 4
SEQ = 2048
DEPTH = 1

CHUNK = 64
N_META = 16
D_SSM = D_MODEL // 2
SSM_GROUP = 16
N_SSM_GROUPS = D_SSM // SSM_GROUP
SSM_STATE = 64
D_CONV = D_MODEL // 2
CONV_WIDTH = 31
D_FF = 4 * D_MODEL
EPS = 1e-6
DT_MIN = 1e-3
DT_MAX = 1e-1

kernel_name = "s5_conformer_gated_hybrid"


def rms_norm(x, g):
    xf = x.astype(jnp.float32)
    y = xf * lax.rsqrt(jnp.mean(xf * xf, axis=-1, keepdims=True) + EPS)
    return (y * g.astype(jnp.float32)).astype(x.dtype)


def layer_norm(x, g, b):
    xf = x.astype(jnp.float32)
    mu = jnp.mean(xf, axis=-1, keepdims=True)
    xc = xf - mu
    y = xc * lax.rsqrt(jnp.mean(xc * xc, axis=-1, keepdims=True) + EPS)
    return (y * g.astype(jnp.float32) + b.astype(jnp.float32)).astype(x.dtype)


def s5_mixer(u, lam_re, lam_im, log_dt, b_re, b_im, c_re, c_im, d_skip):
    bsz, seq_len, _ = u.shape
    uf = u.astype(jnp.float32)
    ug = uf.reshape(bsz, seq_len, N_SSM_GROUPS, SSM_GROUP)
    lam = lax.complex(lam_re.astype(jnp.float32), lam_im.astype(jnp.float32))
    dt = jnp.exp(log_dt.astype(jnp.float32))[:, None]
    lam_bar = jnp.exp(lam * dt)
    b_cplx = lax.complex(b_re.astype(jnp.float32), b_im.astype(jnp.float32))
    b_bar = ((lam_bar - 1.0) / lam)[..., None] * b_cplx
    bu = jnp.einsum('gnh,blgh->blgn', b_bar, ug.astype(jnp.complex64))
    a = jnp.broadcast_to(lam_bar, bu.shape)

    def combine(e1, e2):
        a1, s1 = e1
        a2, s2 = e2
        return a1 * a2, a2 * s1 + s2

    _, states = lax.associative_scan(combine, (a, bu), axis=1)
    y = (jnp.einsum('ghn,blgn->blgh', c_re.astype(jnp.float32), states.real)
         - jnp.einsum('ghn,blgn->blgh', c_im.astype(jnp.float32), states.imag))
    return y.reshape(bsz, seq_len, D_SSM) + d_skip.astype(jnp.float32) * uf


def causal_depthwise_conv(x, w, b):
    k = w.shape[0]
    xp = jnp.pad(x, ((0, 0), (k - 1, 0), (0, 0)))
    y = lax.conv_general_dilated(xp, w[:, None, :].astype(x.dtype), window_strides=(1,),
                                 padding='VALID', dimension_numbers=('NWC', 'WIO', 'NWC'),
                                 feature_group_count=x.shape[-1])
    return y + b.astype(x.dtype)


def setup_inputs(seed: int = 0) -> dict:
    key = jax.random.key(seed)
    ks = jax.random.split(key, 24)
    f32 = jnp.float32
    n_in = D_SSM + 2 * D_CONV + 2 * D_MODEL
    nrm = lambda k, shape, scale: (jax.random.normal(k, shape, f32) * scale).astype(f32)
    x = jax.random.normal(ks[0], (BATCH, SEQ, D_MODEL), f32)
    meta = nrm(ks[1], (N_META, D_MODEL), 1.0)
    norm_mix_g = 1.0 + nrm(ks[2], (DEPTH, D_MODEL), 0.02)
    w_in = nrm(ks[3], (DEPTH, D_MODEL, n_in), D_MODEL ** -0.5)
    lam_re = -0.5 + nrm(ks[4], (DEPTH, N_SSM_GROUPS, SSM_STATE), 0.01)
    lam_im = (math.pi * jnp.arange(SSM_STATE, dtype=f32))[None, None, :] + nrm(ks[5], (DEPTH, N_SSM_GROUPS, SSM_STATE), 0.01)
    log_dt = jax.random.uniform(ks[6], (DEPTH, N_SSM_GROUPS), f32, math.log(DT_MIN), math.log(DT_MAX))
    b_re = nrm(ks[7], (DEPTH, N_SSM_GROUPS, SSM_STATE, SSM_GROUP), (2 * SSM_GROUP) ** -0.5)
    b_im = nrm(ks[8], (DEPTH, N_SSM_GROUPS, SSM_STATE, SSM_GROUP), (2 * SSM_GROUP) ** -0.5)
    c_re = nrm(ks[9], (DEPTH, N_SSM_GROUPS, SSM_GROUP, SSM_STATE), (2 * SSM_STATE) ** -0.5)
    c_im = nrm(ks[10], (DEPTH, N_SSM_GROUPS, SSM_GROUP, SSM_STATE), (2 * SSM_STATE) ** -0.5)
    d_skip = nrm(ks[11], (DEPTH, D_SSM), 1.0)
    w_glu = nrm(ks[12], (DEPTH, D_SSM, 2 * D_MODEL), D_SSM ** -0.5)
    conv_w = nrm(ks[13], (DEPTH, CONV_WIDTH, D_CONV), CONV_WIDTH ** -0.5)
    conv_b = nrm(ks[14], (DEPTH, D_CONV), 0.01)
    conv_ln_g = 1.0 + nrm(ks[15], (DEPTH, D_CONV), 0.02)
    conv_ln_b = nrm(ks[16], (DEPTH, D_CONV), 0.01)
    w_conv_out = nrm(ks[17], (DEPTH, D_CONV, D_MODEL), D_CONV ** -0.5)
    w_out = nrm(ks[18], (DEPTH, D_MODEL, D_MODEL), D_MODEL ** -0.5)
    norm_ffn_g = 1.0 + nrm(ks[19], (DEPTH, D_MODEL), 0.02)
    w_ff1 = nrm(ks[20], (DEPTH, D_MODEL, D_FF), D_MODEL ** -0.5)
    w_ff2 = nrm(ks[21], (DEPTH, D_FF, D_MODEL), D_FF ** -0.5)
    norm_f_g = 1.0 + nrm(ks[22], (D_MODEL,), 0.02)
    return {"x": x, "meta": meta, "norm_mix_g": norm_mix_g, "w_in": w_in,
            "lam_re": lam_re, "lam_im": lam_im, "log_dt": log_dt,
            "b_re": b_re, "b_im": b_im, "c_re": c_re, "c_im": c_im, "d_skip": d_skip,
            "w_glu": w_glu, "conv_w": conv_w, "conv_b": conv_b,
            "conv_ln_g": conv_ln_g, "conv_ln_b": conv_ln_b, "w_conv_out": w_conv_out,
            "w_out": w_out, "norm_ffn_g": norm_ffn_g, "w_ff1": w_ff1, "w_ff2": w_ff2,
            "norm_f_g": norm_f_g}


def reference(x, meta, norm_mix_g, w_in, lam_re, lam_im, log_dt, b_re, b_im, c_re, c_im, d_skip,
              w_glu, conv_w, conv_b, conv_ln_g, conv_ln_b, w_conv_out, w_out, norm_ffn_g,
              w_ff1, w_ff2, norm_f_g):
    bsz = x.shape[0]
    h_res = jnp.concatenate([jnp.broadcast_to(meta.astype(x.dtype)[None], (bsz, N_META, D_MODEL)), x], axis=1)
    split_pts = [D_SSM, D_SSM + 2 * D_CONV, D_SSM + 2 * D_CONV + D_MODEL]
    for l in range(DEPTH):
        h = rms_norm(h_res, norm_mix_g[l])
        proj = h @ w_in[l]
        u, cv, ga, gb = jnp.split(proj, split_pts, axis=-1)
        y = s5_mixer(u, lam_re[l], lam_im[l], log_dt[l], b_re[l], b_im[l], c_re[l], c_im[l], d_skip[l])
        z = jax.nn.gelu(y).astype(x.dtype)
        za, zb = jnp.split(z @ w_glu[l], 2, axis=-1)
        out_a = za * jax.nn.sigmoid(zb)
        c1, c2 = jnp.split(cv, 2, axis=-1)
        c = c1 * jax.nn.sigmoid(c2)
        c = causal_depthwise_conv(c, conv_w[l], conv_b[l])
        c = jax.nn.silu(layer_norm(c, conv_ln_g[l], conv_ln_b[l]))
        out_b = c @ w_conv_out[l]
        merged = jax.nn.sigmoid(ga) * out_a + jax.nn.sigmoid(gb) * out_b
        h_res = h_res + merged @ w_out[l]
        h = rms_norm(h_res, norm_ffn_g[l])
        h_res = h_res + jnp.square(jax.nn.relu(h @ w_ff1[l])) @ w_ff2[l]
    out = rms_norm(h_res, norm_f_g)
    return out[:, N_META:, :]
```

```cpp
#include <hip/hip_runtime.h>
#include <hip/hip_cooperative_groups.h>
#include <cstdio>
namespace cg = cooperative_groups;
namespace pg8 {
#define PG8_LAS __attribute__((address_space(3)))
typedef unsigned short bf16_t;
typedef short bf16x8 __attribute__((ext_vector_type(8)));
typedef float f32x4 __attribute__((ext_vector_type(4)));
typedef unsigned u32x4 __attribute__((ext_vector_type(4)));
constexpr int BM = 256, BK = 64, HALF = 128, HTB = HALF * BK * 2  , STAGE_BYTES = 8 * HTB, NXCD = 8, WGM = 8;

__host__ __device__ __forceinline__ int lds_byte(int r, int c) { const int st = (r >> 4) * 2 + (c >> 5), rr = r & 15, cc = c & 31, ob = rr * 64 + cc * 2; return st * 1024 + (ob ^ (((ob >> 9) & 1) << 5)); }
__host__ __device__ __forceinline__ void stage_rc(int b, int& R, int& C) { const int st = b / 1024, sb = b % 1024, swz = sb ^ (((sb >> 9) & 1) << 5); R = (st >> 1) * 16 + swz / 64; C = (st & 1) * 32 + (swz % 64) / 2; }
__host__ __device__ __forceinline__ int perm32(int rho) { const int n = rho >> 4, i = rho & 15; return 8 * (i >> 2) + 4 * n + (i & 3); }

struct Unit { int pm, pn, kind; };
struct Gemm { const bf16_t* A; const bf16_t* Bt; int M, N, K; const bf16_t* A2; const bf16_t* Bt2; };

struct StaticOrder {
    int nM, nN, nwg, G, c;
    __host__ __device__ void init(int M, int N, int G_, int c_) { nM = M / BM; nN = N / BM; nwg = nM * nN; G = G_; c = c_; }
    __host__ __device__ bool next(int i, Unit& u) const {
        const long L = (long)i * G + c; if (L >= nwg) return false;
        int wgid = (int)L; { const int q = nwg / NXCD, r = nwg % NXCD, xcd = wgid % NXCD, off = wgid / NXCD; wgid = (xcd < r ? xcd * (q + 1) : r * (q + 1) + (xcd - r) * q) + off; }
        const int nig = WGM * nN, gid = wgid / nig, fm = gid * WGM, gsz = (nM - fm) < WGM ? (nM - fm) : WGM;
        u.pm = fm + ((wgid % nig) % gsz); u.pn = (wgid % nig) / gsz; return true;
    }
    __device__ __forceinline__ void a_ready(const Unit&) const {}
    __device__ __forceinline__ void done(const Unit&) const {}
};
typedef float f32x2c __attribute__((ext_vector_type(2)));
typedef __bf16 bf16x2c __attribute__((ext_vector_type(2)));
__device__ __forceinline__ unsigned cvt_pk_bf16(float lo, float hi) { const f32x2c v = {lo, hi}; return __builtin_bit_cast(unsigned, __builtin_convertvector(v, bf16x2c)); }

template <class Epi, class Sched, bool HETERO = false, bool ATILED = false>
__device__ __forceinline__ void gemm_phase(PG8_LAS unsigned char* lds, const Gemm g, const Sched& S, const Epi& E) {
    const int tid = threadIdx.x, wid = __builtin_amdgcn_readfirstlane(tid >> 6), lane = tid & 63, wr = wid >> 2, wc = wid & 3, fr = lane & 15, fq = lane >> 4;
    const int K = g.K, nt = K / BK;
    unsigned voffA[2], voffB[2];
#pragma unroll
    for (int i = 0; i < 2; ++i) { int R, C; stage_rc(tid * 16 + i * 8192, R, C); const int Rb = Epi::PERM ? ((R & ~31) + perm32(R & 31)) : R;
        voffA[i] = (unsigned)(R * (ATILED ? BK : K) + C) * 2u; voffB[i] = (unsigned)(Rb * BK + C) * 2u; }
    const size_t kstep = ATILED ? (size_t)BM * BK * 2 : (size_t)(BK * 2);
    const size_t hstep = ATILED ? (size_t)HALF * BK * 2 : (size_t)HALF * K * 2;
    const size_t tstep = (size_t)BM * K * 2;
    const size_t kstepB = (size_t)BM * BK * 2, hstepB = (size_t)HALF * BK * 2, tstepB = (size_t)nt * kstepB;
    const unsigned ldsw = (unsigned)wid * 1024u;
    const int aoff = lds_byte(wr * 64 + fr, fq * 8), boff = lds_byte(wc * 32 + fr, fq * 8);
#define PG8_SA(b, h) (((b) * 2 + (h)) * HTB)
#define PG8_SB(b, h) ((4 + (b) * 2 + (h)) * HTB)
#define PG8_STAGE(bufoff, gbase, voff) do { _Pragma("unroll") for (int _i = 0; _i < 2; ++_i) \
        __builtin_amdgcn_global_load_lds((const unsigned*)((const char*)(gbase) + (voff)[_i]), (PG8_LAS unsigned*)(lds + (bufoff) + ldsw + _i * 8192), 16, 0, 0); } while (0)
#define PG8_LDA(dst, b, h) do { _Pragma("unroll") for (int m = 0; m < 4; ++m) _Pragma("unroll") for (int k = 0; k < 2; ++k) dst[m][k] = *(const PG8_LAS bf16x8*)(lds + PG8_SA(b, h) + aoff + m * 2048 + k * 1024); } while (0)
#define PG8_LDB(dst, b, h) do { _Pragma("unroll") for (int n = 0; n < 2; ++n) _Pragma("unroll") for (int k = 0; k < 2; ++k) dst[n][k] = *(const PG8_LAS bf16x8*)(lds + PG8_SB(b, h) + boff + n * 2048 + k * 1024); } while (0)
#define PG8_MMA(ai, bj, At, Bt) do { __builtin_amdgcn_s_setprio(1); _Pragma("unroll") for (int m = 0; m < 4; ++m) _Pragma("unroll") for (int n = 0; n < 2; ++n) _Pragma("unroll") for (int k = 0; k < 2; ++k) \
        acc[ai][bj][m][n] = __builtin_amdgcn_mfma_f32_16x16x32_bf16(Bt[n][k], At[m][k], acc[ai][bj][m][n], 0, 0, 0); __builtin_amdgcn_s_setprio(0); } while (0)
#define PG8_WAIT_V(n) asm volatile("s_waitcnt vmcnt(" #n ")" ::: "memory")
#define PG8_WAIT_L(n) asm volatile("s_waitcnt lgkmcnt(" #n ")" ::: "memory")
#define PG8_BAR __builtin_amdgcn_s_barrier()
#define PG8_SCHED __builtin_amdgcn_sched_barrier(0)
    Unit cur, nxt; int ui = 0;
    if (!S.next(0, cur)) return;
    f32x4 acc[2][2][4][2];
#pragma unroll
    for (int a = 0; a < 2; ++a)
#pragma unroll
        for (int b = 0; b < 2; ++b)
#pragma unroll
            for (int m = 0; m < 4; ++m)
#pragma unroll
                for (int n = 0; n < 2; ++n) acc[a][b][m][n] = (f32x4){0.f, 0.f, 0.f, 0.f};
    bf16x8 At[4][2], B0[2][2], B1[2][2];
    const char* cA = (const char*)((HETERO && cur.kind) ? g.A2 : g.A) + (size_t)cur.pm * tstep; const char* cB = (const char*)((HETERO && cur.kind) ? g.Bt2 : g.Bt) + (size_t)cur.pn * tstepB;
    S.a_ready(cur);
    PG8_STAGE(PG8_SB(0, 0), cB, voffB); PG8_STAGE(PG8_SA(0, 0), cA, voffA); PG8_STAGE(PG8_SB(0, 1), cB + hstepB, voffB); PG8_STAGE(PG8_SA(0, 1), cA + hstep, voffA);
    if (wr == 1) PG8_BAR;
    PG8_WAIT_V(4); PG8_BAR;
    PG8_STAGE(PG8_SB(1, 0), cB + kstepB, voffB); PG8_STAGE(PG8_SA(1, 0), cA + kstep, voffA); PG8_STAGE(PG8_SB(1, 1), cB + hstepB + kstepB, voffB);
    PG8_WAIT_V(6); PG8_BAR;
    for (;;) {
        const bool has_next = S.next(ui + 1, nxt);
        const char* nA = has_next ? (const char*)((HETERO && nxt.kind) ? g.A2 : g.A) + (size_t)nxt.pm * tstep : cA; const char* nB = has_next ? (const char*)((HETERO && nxt.kind) ? g.Bt2 : g.Bt) + (size_t)nxt.pn * tstepB : cB;
        for (int t = 0; t < nt; t += 2) {
            const bool last = (t == nt - 2);
            const char* a1 = cA + (size_t)(t + 1) * kstep;
            const char* a2 = last ? nA : cA + (size_t)(t + 2) * kstep; const char* b2 = last ? nB : cB + (size_t)(t + 2) * kstepB;
            const char* a3 = a2 + kstep; const char* b3 = b2 + kstepB;
            if (last && has_next) S.a_ready(nxt);
            PG8_LDB(B0, 0, 0); PG8_SCHED; PG8_LDA(At, 0, 0); PG8_STAGE(PG8_SA(1, 1), a1 + hstep, voffA);
            PG8_WAIT_L(8); PG8_BAR; PG8_WAIT_L(0); PG8_MMA(0, 0, At, B0); PG8_BAR; PG8_SCHED;
            PG8_LDB(B1, 0, 1); PG8_STAGE(PG8_SB(0, 0), b2, voffB);
            PG8_BAR; PG8_WAIT_L(0); PG8_MMA(0, 1, At, B1); PG8_BAR;
            PG8_LDA(At, 0, 1); PG8_STAGE(PG8_SA(0, 0), a2, voffA);
            PG8_BAR; PG8_WAIT_L(0); PG8_MMA(1, 0, At, B0); PG8_BAR; PG8_SCHED;
            PG8_STAGE(PG8_SB(0, 1), b2 + hstepB, voffB);
            PG8_WAIT_V(6); PG8_BAR; PG8_MMA(1, 1, At, B1); PG8_BAR;
            PG8_LDB(B0, 1, 0); PG8_SCHED; PG8_LDA(At, 1, 0); PG8_STAGE(PG8_SA(0, 1), a2 + hstep, voffA);
            PG8_WAIT_L(8); PG8_BAR; PG8_WAIT_L(0); PG8_MMA(0, 0, At, B0); PG8_BAR; PG8_SCHED;
            PG8_LDB(B1, 1, 1); PG8_STAGE(PG8_SB(1, 0), b3, voffB);
            PG8_BAR; PG8_WAIT_L(0); PG8_MMA(0, 1, At, B1); PG8_BAR;
            PG8_LDA(At, 1, 1); PG8_STAGE(PG8_SA(1, 0), a3, voffA);
            PG8_BAR; PG8_WAIT_L(0); PG8_MMA(1, 0, At, B0); PG8_BAR; PG8_SCHED;
            PG8_STAGE(PG8_SB(1, 1), b3 + hstepB, voffB);
            PG8_WAIT_V(6); PG8_BAR; PG8_MMA(1, 1, At, B1); PG8_BAR;
        }
        if constexpr (!Epi::AFTER_DRAIN) { E(acc, cur, wr, wc, fr, fq); S.done(cur); }
        if (!has_next) break;
#pragma unroll
        for (int a = 0; a < 2; ++a)
#pragma unroll
            for (int b = 0; b < 2; ++b)
#pragma unroll
                for (int m = 0; m < 4; ++m)
#pragma unroll
                    for (int n = 0; n < 2; ++n) acc[a][b][m][n] = (f32x4){0.f, 0.f, 0.f, 0.f};
        cur = nxt; cA = nA; cB = nB; ++ui;
    }
    PG8_WAIT_V(0);
    if (wr == 0) PG8_BAR;
    PG8_BAR;
    if constexpr (Epi::AFTER_DRAIN) { E.fused(acc, cur, wr, wc, fr, fq, lds, wid, lane); S.done(cur); }
#undef PG8_SA
#undef PG8_SB
#undef PG8_STAGE
#undef PG8_LDA
#undef PG8_LDB
#undef PG8_MMA
#undef PG8_WAIT_V
#undef PG8_WAIT_L
#undef PG8_BAR
#undef PG8_SCHED
}
}

using pg8::bf16_t; using pg8::bf16x8; using pg8::f32x4; using pg8::u32x4; using pg8::Unit; using pg8::cvt_pk_bf16;
#define LAS __attribute__((address_space(3)))
typedef float f32x16 __attribute__((ext_vector_type(16)));
typedef float f32x2 __attribute__((ext_vector_type(2)));
typedef unsigned u32x2 __attribute__((ext_vector_type(2)));

constexpr int T = 8192, DM = 2048, MP = 8448, NIN = 7168, DFF = 8192, DS = 1024;
constexpr float EPS = 1e-6f;
constexpr int LDS_MAIN = 131072, LDS_BYTES = LDS_MAIN + 16;
constexpr size_t OFF_WFF1 = 0, OFF_WFF2 = 33554432, OFF_WOUT = 67108864, OFF_WGLU = 75497472, OFF_WCO = 83886080, OFF_WIN = 88080384,
                 OFF_A0 = 117440512, OFF_CG = 152043520, OFF_U = 169345024, OFF_SG = 186646528, OFF_CS = 253755392, OFF_SMALL = 287309824;
constexpr size_t OFF_SS2 = OFF_SMALL, OFF_SS3 = OFF_SS2 + 1048576, OFF_A1 = OFF_SS3 + 1048576, OFF_A16 = OFF_A1 + 32768, OFF_A64 = OFF_A16 + 32768,
                 OFF_BMT = OFF_A64 + 32768, OFF_CMT = OFF_BMT + 262144, OFF_CNT = OFF_CMT + 262144, OFF_QCTR = OFF_CNT + 32 * 256, OFF_BAR = OFF_QCTR + 256, WS_END = OFF_BAR + 16384;
constexpr size_t OFF_E = OFF_WIN, OFF_Z = OFF_E + 4227072, OFF_TB = OFF_A0, OFF_MG = OFF_CG, OFF_HG = OFF_WIN, OFF_ACT = OFF_HG + 33554432;
static_assert(OFF_Z + 16777216 <= OFF_A0, "Z overlay");
static_assert(OFF_TB + 33554432 <= OFF_CG, "TB overlay");
static_assert(OFF_MG + 33554432 <= OFF_SG, "MG overlay");
static_assert(OFF_CS + 16777216 <= OFF_SMALL, "CS region");
static_assert(OFF_ACT + 134217728 <= OFF_SMALL, "ACT overlay");

struct Params { const float* in[23]; float* out; unsigned char* ws; int ph_lo, ph_hi; };

__device__ __forceinline__ float sigm(float x) { return __builtin_amdgcn_rcpf(1.0f + __expf(-x)); }
__device__ __forceinline__ size_t sgidx(int row, int col) { return ((size_t)(row >> 8) * 32 + (col >> 7)) * 32768 + (size_t)((row & 255) * 128 + (col & 127)); }
__device__ __forceinline__ float bflo(unsigned w) { return __uint_as_float(w << 16); }
__device__ __forceinline__ float bfhi(unsigned w) { return __uint_as_float(w & 0xffff0000u); }
__device__ __forceinline__ u32x4 pack8(f32x4 a, f32x4 b) { u32x4 w; w.x = cvt_pk_bf16(a[0], a[1]); w.y = cvt_pk_bf16(a[2], a[3]); w.z = cvt_pk_bf16(b[0], b[1]); w.w = cvt_pk_bf16(b[2], b[3]); return w; }
__device__ __forceinline__ void unpack8(u32x4 w, f32x4& a, f32x4& b) { a[0] = bflo(w.x); a[1] = bfhi(w.x); a[2] = bflo(w.y); a[3] = bfhi(w.y); b[0] = bflo(w.z); b[1] = bfhi(w.z); b[2] = bflo(w.w); b[3] = bfhi(w.w); }
__device__ __forceinline__ float wave_sum(float v) { v += __shfl_xor(v, 32); v += __shfl_xor(v, 16); v += __shfl_xor(v, 8); v += __shfl_xor(v, 4); v += __shfl_xor(v, 2); v += __shfl_xor(v, 1); return v; }

struct Epi1 {
    static constexpr bool PERM = true, AFTER_DRAIN = false;
    bf16_t* U; bf16_t* Cg; bf16_t* SG;
    __device__ __forceinline__ void operator()(const f32x4 (&acc)[2][2][4][2], const Unit& u, int wr, int wc, int fr, int fq) const {
        const int row0 = u.pm * 256 + wr * 64 + fr, cl = wc * 32 + 8 * fq;
        if (u.pn < 4) {
#pragma unroll
            for (int ai = 0; ai < 2; ++ai)
#pragma unroll
                for (int m = 0; m < 4; ++m) { bf16_t* rowp = U + (size_t)(row0 + ai * 128 + m * 16) * DS + u.pn * 256 + cl;
#pragma unroll
                    for (int bj = 0; bj < 2; ++bj) *(u32x4*)(rowp + bj * 128) = pack8(acc[ai][bj][m][0], acc[ai][bj][m][1]); }
        } else if (u.pn < 12) {
#pragma unroll
            for (int ai = 0; ai < 2; ++ai)
#pragma unroll
                for (int m = 0; m < 4; ++m) { bf16_t* rowp = Cg + (size_t)(row0 + ai * 128 + m * 16) * DS + (u.pn - 4) * 128 + cl;
                    f32x4 v0, v1;
#pragma unroll
                    for (int j = 0; j < 4; ++j) { v0[j] = acc[ai][0][m][0][j] * sigm(acc[ai][1][m][0][j]); v1[j] = acc[ai][0][m][1][j] * sigm(acc[ai][1][m][1][j]); }
                    *(u32x4*)rowp = pack8(v0, v1); }
        } else {
#pragma unroll
            for (int ai = 0; ai < 2; ++ai)
#pragma unroll
                for (int m = 0; m < 4; ++m) { const int srow = row0 + ai * 128 + m * 16, scol = (u.pn - 12) * 256 + cl;
#pragma unroll
                    for (int bj = 0; bj < 2; ++bj) { f32x4 v0, v1;
#pragma unroll
                        for (int j = 0; j < 4; ++j) { v0[j] = sigm(acc[ai][bj][m][0][j]); v1[j] = sigm(acc[ai][bj][m][1][j]); }
                        *(u32x4*)(SG + sgidx(srow, scol + bj * 128)) = pack8(v0, v1); } }
        }
    }
};
struct EpiCo {
    static constexpr bool PERM = true, AFTER_DRAIN = false;
    const bf16_t* SG; bf16_t* TB;
    __device__ __forceinline__ void operator()(const f32x4 (&acc)[2][2][4][2], const Unit& u, int wr, int wc, int fr, int fq) const {
        const int row0 = u.pm * 256 + wr * 64 + fr, cl = u.pn * 256 + wc * 32 + 8 * fq;
#pragma unroll
        for (int ai = 0; ai < 2; ++ai)
#pragma unroll
            for (int m = 0; m < 4; ++m) { const size_t row = (size_t)(row0 + ai * 128 + m * 16);
#pragma unroll
                for (int bj = 0; bj < 2; ++bj) { const u32x4 s = *(const u32x4*)(SG + sgidx((int)row, 2048 + cl + bj * 128)); f32x4 s0, s1; unpack8(s, s0, s1);
                    *(u32x4*)(TB + row * DM + cl + bj * 128) = pack8(acc[ai][bj][m][0] * s0, acc[ai][bj][m][1] * s1); } }
    }
};
struct EpiGlu {
    static constexpr bool PERM = true, AFTER_DRAIN = false;
    const bf16_t* SG; const bf16_t* TB; bf16_t* MG;
    __device__ __forceinline__ void operator()(const f32x4 (&acc)[2][2][4][2], const Unit& u, int wr, int wc, int fr, int fq) const {
        const int row0 = u.pm * 256 + wr * 64 + fr, cl = u.pn * 128 + wc * 32 + 8 * fq;
#pragma unroll
        for (int ai = 0; ai < 2; ++ai)
#pragma unroll
            for (int m = 0; m < 4; ++m) { const size_t row = (size_t)(row0 + ai * 128 + m * 16);
                const u32x4 s = *(const u32x4*)(SG + sgidx((int)row, cl)); const u32x4 t = *(const u32x4*)(TB + row * DM + cl);
                f32x4 s0, s1, t0, t1, v0, v1; unpack8(s, s0, s1); unpack8(t, t0, t1);
#pragma unroll
                for (int j = 0; j < 4; ++j) { v0[j] = s0[j] * acc[ai][0][m][0][j] * sigm(acc[ai][1][m][0][j]) + t0[j]; v1[j] = s1[j] * acc[ai][0][m][1][j] * sigm(acc[ai][1][m][1][j]) + t1[j]; }
                *(u32x4*)(MG + row * DM + cl) = pack8(v0, v1); }
    }
};
struct EpiOut {
    static constexpr bool PERM = true, AFTER_DRAIN = false;
    const float* X; bf16_t* H2B; float* SS;
    __device__ __forceinline__ void operator()(const f32x4 (&acc)[2][2][4][2], const Unit& u, int wr, int wc, int fr, int fq) const {
        const int row0 = u.pm * 256 + wr * 64 + fr, cl = u.pn * 256 + wc * 32 + 8 * fq;
#pragma unroll
        for (int ai = 0; ai < 2; ++ai)
#pragma unroll
            for (int m = 0; m < 4; ++m) { const size_t row = (size_t)(row0 + ai * 128 + m * 16); float ss = 0.f;
#pragma unroll
                for (int bj = 0; bj < 2; ++bj) { const size_t o = row * DM + cl + bj * 128;
                    const f32x4 h0 = __builtin_nontemporal_load((const f32x4*)(X + o)) + acc[ai][bj][m][0], h1 = __builtin_nontemporal_load((const f32x4*)(X + o + 4)) + acc[ai][bj][m][1];
                    ss += (h0[0] * h0[0] + h0[1] * h0[1]) + (h0[2] * h0[2] + h0[3] * h0[3]) + (h1[0] * h1[0] + h1[1] * h1[1]) + (h1[2] * h1[2] + h1[3] * h1[3]);
                    *(u32x4*)(H2B + o) = pack8(h0, h1); }
                ss += __shfl_xor(ss, 16); ss += __shfl_xor(ss, 32);
                if (fq == 0) SS[row * 32 + u.pn * 4 + wc] = ss;
                if (m & 1) asm volatile("" ::: "memory"); }
    }
};
struct EpiFf1 {
    static constexpr bool PERM = true, AFTER_DRAIN = false;
    bf16_t* ACT;
    __device__ __forceinline__ void operator()(const f32x4 (&acc)[2][2][4][2], const Unit& u, int wr, int wc, int fr, int fq) const {
        const int row0 = u.pm * 256 + wr * 64 + fr, cl = u.pn * 256 + wc * 32 + 8 * fq;
#pragma unroll
        for (int ai = 0; ai < 2; ++ai)
#pragma unroll
            for (int m = 0; m < 4; ++m) { const int row = row0 + ai * 128 + m * 16;
#pragma unroll
                for (int bj = 0; bj < 2; ++bj) { f32x4 v0, v1;
#pragma unroll
                    for (int j = 0; j < 4; ++j) { const float a = fmaxf(acc[ai][bj][m][0][j], 0.f), b = fmaxf(acc[ai][bj][m][1][j], 0.f); v0[j] = a * a; v1[j] = b * b; }
                    const int col = cl + bj * 128; *(u32x4*)(ACT + ((size_t)(row >> 8) * (DFF / 64) + (col >> 6)) * 16384 + (row & 255) * 64 + (col & 63)) = pack8(v0, v1); } }
    }
};
struct EpiFf2 {
    static constexpr bool PERM = true, AFTER_DRAIN = false;
    const bf16_t* H2B; float* H; const float* SS2; float* SS3;
    __device__ __forceinline__ void operator()(const f32x4 (&acc)[2][2][4][2], const Unit& u, int wr, int wc, int fr, int fq) const {
        const int row0 = u.pm * 256 + wr * 64 + fr, cl = u.pn * 256 + wc * 32 + 8 * fq;
#pragma unroll
        for (int ai = 0; ai < 2; ++ai)
#pragma unroll
            for (int m = 0; m < 4; ++m) { const size_t row = (size_t)(row0 + ai * 128 + m * 16);
                const f32x4 p0 = *(const f32x4*)(SS2 + row * 32 + fq * 8), p1 = *(const f32x4*)(SS2 + row * 32 + fq * 8 + 4);
                float t = ((p0[0] + p0[1]) + (p0[2] + p0[3])) + ((p1[0] + p1[1]) + (p1[2] + p1[3]));
                t += __shfl_xor(t, 16); t += __shfl_xor(t, 32);
                const float rs2 = 1.0f / (t * (1.0f / 2048.0f) + EPS); float ss = 0.f;
#pragma unroll
                for (int bj = 0; bj < 2; ++bj) { const size_t o = row * DM + cl + bj * 128;
                    f32x4 r0, r1; unpack8(*(const u32x4*)(H2B + o), r0, r1);
                    const f32x4 h0 = r0 + rs2 * acc[ai][bj][m][0], h1 = r1 + rs2 * acc[ai][bj][m][1];
                    *(f32x4*)(H + o) = h0; *(f32x4*)(H + o + 4) = h1;
                    ss += (h0[0] * h0[0] + h0[1] * h0[1]) + (h0[2] * h0[2] + h0[3] * h0[3]) + (h1[0] * h1[0] + h1[1] * h1[1]) + (h1[2] * h1[2] + h1[3] * h1[3]); }
                ss += __shfl_xor(ss, 16); ss += __shfl_xor(ss, 32);
                if (fq == 0) SS3[row * 32 + u.pn * 4 + wc] = ss;
                if (m & 1) asm volatile("" ::: "memory"); }
    }
};
struct EpiFf2N {
    static constexpr bool PERM = true, AFTER_DRAIN = true;
    const bf16_t* H2B; float* OUT; const float* SS2; float* XP; unsigned* CNT; const float* GF;
    __device__ __forceinline__ void fused(f32x4 (&acc)[2][2][4][2], const Unit& u, int wr, int wc, int fr, int fq, LAS unsigned char* lds, int wid, int lane) const {
        LAS float* P = (LAS float*)lds;
        LAS float* S = (LAS float*)(lds + 4096);
        const int row0 = u.pm * 256 + wr * 64 + fr, cl = u.pn * 256 + wc * 32 + 8 * fq;
#pragma unroll
        for (int ai = 0; ai < 2; ++ai)
#pragma unroll
            for (int m = 0; m < 4; ++m) { const size_t row = (size_t)(row0 + ai * 128 + m * 16);
                const f32x4 p0 = *(const f32x4*)(SS2 + row * 32 + fq * 8), p1 = *(const f32x4*)(SS2 + row * 32 + fq * 8 + 4);
                float t = ((p0[0] + p0[1]) + (p0[2] + p0[3])) + ((p1[0] + p1[1]) + (p1[2] + p1[3]));
                t += __shfl_xor(t, 16); t += __shfl_xor(t, 32);
                const float rs2 = 1.0f / (t * (1.0f / 2048.0f) + EPS); float ss = 0.f;
#pragma unroll
                for (int bj = 0; bj < 2; ++bj) { const size_t o = row * DM + cl + bj * 128;
                    f32x4 r0, r1; unpack8(*(const u32x4*)(H2B + o), r0, r1);
                    const f32x4 h0 = r0 + rs2 * acc[ai][bj][m][0], h1 = r1 + rs2 * acc[ai][bj][m][1];
                    acc[ai][bj][m][0] = h0; acc[ai][bj][m][1] = h1;
                    ss += (h0[0] * h0[0] + h0[1] * h0[1]) + (h0[2] * h0[2] + h0[3] * h0[3]) + (h1[0] * h1[0] + h1[1] * h1[1]) + (h1[2] * h1[2] + h1[3] * h1[3]); }
                ss += __shfl_xor(ss, 16); ss += __shfl_xor(ss, 32);
                if (fq == 0) P[(ai * 128 + wr * 64 + m * 16 + fr) * 4 + wc] = ss;
                if (m & 1) asm volatile("" ::: "memory"); }
        asm volatile("s_waitcnt lgkmcnt(0)" ::: "memory"); __builtin_amdgcn_s_barrier(); asm volatile("" ::: "memory");
        const int tid = wid * 64 + lane;
        if (tid < 256) { const f32x4 q = *(const LAS f32x4*)(P + tid * 4);
            __hip_atomic_store(XP + (size_t)(u.pm * 256 + tid) * 8 + u.pn, (q[0] + q[1]) + (q[2] + q[3]), __ATOMIC_RELAXED, __HIP_MEMORY_SCOPE_AGENT); }
        asm volatile("s_waitcnt vmcnt(0)" ::: "memory");
        if (wid < 4 && lane == 0) __hip_atomic_fetch_add(CNT + 64 * u.pm, 1u, __ATOMIC_RELAXED, __HIP_MEMORY_SCOPE_AGENT);
        if (wid == 0) {
            while ((unsigned)__builtin_amdgcn_readfirstlane(__hip_atomic_load(CNT + 64 * u.pm, __ATOMIC_RELAXED, __HIP_MEMORY_SCOPE_AGENT)) < 32u) __builtin_amdgcn_s_sleep(2);
            __builtin_amdgcn_fence(__ATOMIC_ACQUIRE, "agent");
        }
        asm volatile("s_waitcnt vmcnt(0) lgkmcnt(0)" ::: "memory"); __builtin_amdgcn_s_barrier(); asm volatile("" ::: "memory");
        if (tid < 256) { const float* xp = XP + (size_t)(u.pm * 256 + tid) * 8; float t = 0.f;
#pragma unroll
            for (int k = 0; k < 8; ++k) t += __hip_atomic_load(xp + k, __ATOMIC_RELAXED, __HIP_MEMORY_SCOPE_AGENT);
            S[tid] = rsqrtf(t * (1.0f / 2048.0f) + EPS); }
        asm volatile("s_waitcnt vmcnt(0) lgkmcnt(0)" ::: "memory"); __builtin_amdgcn_s_barrier(); asm volatile("" ::: "memory");
        f32x4 gv[2][2];
#pragma unroll
        for (int bj = 0; bj < 2; ++bj)
#pragma unroll
            for (int n = 0; n < 2; ++n) gv[bj][n] = *(const f32x4*)(GF + cl + bj * 128 + 4 * n);
#pragma unroll
        for (int ai = 0; ai < 2; ++ai)
#pragma unroll
            for (int m = 0; m < 4; ++m) { const int rl = ai * 128 + wr * 64 + m * 16 + fr; const float rstd = S[rl]; float* rowp = OUT + (size_t)(u.pm * 256 + rl) * DM + cl;
#pragma unroll
                for (int bj = 0; bj < 2; ++bj) { *(f32x4*)(rowp + bj * 128) = acc[ai][bj][m][0] * rstd * gv[bj][0]; *(f32x4*)(rowp + bj * 128 + 4) = acc[ai][bj][m][1] * rstd * gv[bj][1]; } }
    }
};
struct EpiCoGlu {
    static constexpr bool PERM = true, AFTER_DRAIN = false;
    EpiCo co; EpiGlu glu;
    __device__ __forceinline__ void operator()(const f32x4 (&acc)[2][2][4][2], const Unit& u, int wr, int wc, int fr, int fq) const {
        if (u.kind == 0) { co(acc, u, wr, wc, fr, fq); asm volatile("s_waitcnt vmcnt(0)" ::: "memory"); }
        else glu(acc, u, wr, wc, fr, fq);
    }
};
struct TripleOrder {
    pg8::StaticOrder S8;
    __device__ void init(int G_, int c_) { S8.init(T, DM, G_, c_); }
    __device__ bool next(int i, Unit& u) const { if (i > 2) return false; Unit t; if (!S8.next(0, t)) return false;
        u.pm = t.pm; if (i == 0) { u.pn = t.pn; u.kind = 0; } else { u.pn = 2 * t.pn + (i - 1); u.kind = 1; } return true; }
    __device__ __forceinline__ void a_ready(const Unit&) const {}
    __device__ __forceinline__ void done(const Unit&) const {}
};
struct Order1 : pg8::StaticOrder {
    pg8::StaticOrder S20;
    __device__ void init1(int G_, int c_) { init(T, NIN, G_, c_); S20.init(T, 20 * 256, G_, c_); }
    __device__ bool next(int i, Unit& u) const { const long L = (long)i * G + c;
        if (G == 256) {
            if (i >= 3) return false;
            if (L < 640) { (void)S20.next(i, u); if (u.pn >= 12) u.pn += 8; return true; }
            if (L < 652) { u.pm = 32; u.pn = (int)(L - 640); return true; }
            const int t = (int)(L - 652); u.pm = t >> 3; u.pn = 12 + (t & 7); return true;
        }
        if (L < nwg) return pg8::StaticOrder::next(i, u);
        if (L < nwg + 12) { u.pm = 32; u.pn = (int)(L - nwg); return true; } return false; }
};
struct DeferredOrder {
    int c;
    __device__ bool next(int i, Unit& u) const { if (i > 0) return false; const int t = 116 + c; u.pm = t >> 3; u.pn = 12 + (t & 7); return true; }
    __device__ __forceinline__ void a_ready(const Unit&) const {}
    __device__ __forceinline__ void done(const Unit&) const {}
};

__device__ __forceinline__ int srccol(int mode, int nb) {
    if (mode == 1) { if (nb < 1024 || nb >= 3072) return nb; const int q = (nb - 1024) >> 8, r = (nb - 1024) & 255; return r < 128 ? 1024 + 128 * q + r : 2048 + 128 * q + (r - 128); }
    if (mode == 2) { const int q = nb >> 8, r = nb & 255; return r < 128 ? 128 * q + r : 2048 + 128 * q + (r - 128); }
    return nb;
}
__device__ __forceinline__ void convert_tile(const float* __restrict__ W, bf16_t* __restrict__ Bt, int K, int N, int mode, int kt, int nt, LAS float* tile, int tid, const float* __restrict__ kscale) {
    const int w = tid >> 6, l = tid & 63, k0 = kt * 64, n0 = nt * 256;
    float v[32];
    int sc[4];
#pragma unroll
    for (int s = 0; s < 4; ++s) sc[s] = srccol(mode, n0 + 64 * s) + l;
#pragma unroll
    for (int i = 0; i < 32; ++i) v[i] = __builtin_nontemporal_load(W + (size_t)(k0 + w * 8 + (i >> 2)) * N + sc[i & 3]);
    if (kscale) {
#pragma unroll
        for (int i = 0; i < 32; i += 4) { const float g = kscale[k0 + w * 8 + (i >> 2)]; v[i] *= g; v[i + 1] *= g; v[i + 2] *= g; v[i + 3] *= g; }
    }
#pragma unroll
    for (int i = 0; i < 32; ++i) tile[(w * 8 + (i >> 2)) * 257 + 64 * (i & 3) + l] = v[i];
    __syncthreads();
#pragma unroll
    for (int p = 0; p < 4; ++p) { const int item = tid + 512 * p, nn = item >> 3, kc = (item & 7) * 8;
        f32x4 a, b;
#pragma unroll
        for (int j = 0; j < 4; ++j) { a[j] = tile[(kc + j) * 257 + nn]; b[j] = tile[(kc + 4 + j) * 257 + nn]; }
        *(u32x4*)(Bt + (((size_t)nt * (K / 64) + kt) * 256 + nn) * 64 + kc) = pack8(a, b); }
    __syncthreads();
}
__device__ __forceinline__ void dsincos(double x, double& s, double& c) {
    const double k = rint(x * 0.15915494309189535);
    double r = fma(-k, 6.283185307179586, x); r = fma(-k, 2.4492935982947064e-16, r);
    const double y = r * (1.0 / 1024.0), y2 = y * y;
    s = y * (1.0 - y2 / 6.0 * (1.0 - y2 / 20.0 * (1.0 - y2 / 42.0)));
    c = 1.0 - y2 / 2.0 * (1.0 - y2 / 12.0 * (1.0 - y2 / 30.0 * (1.0 - y2 / 56.0)));
#pragma unroll 1
    for (int i = 0; i < 10; ++i) { const double s2 = 2.0 * s * c, c2 = c * c - s * s; s = s2; c = c2; }
}
__device__ void s5_constants(const Params& p, int first, int stride) {
    unsigned char* ws = p.ws;
    for (int item = first; item < 4096; item += stride) {
        const int g = item >> 6, n = item & 63;
        const double dt = exp((double)p.in[6][g]);
        const double lr = (double)p.in[4][item], li = (double)p.in[5][item];
        const double mag = exp(lr * dt); double sn, cs; dsincos(li * dt, sn, cs);
        double ar = mag * cs, ai = mag * sn;
        const double nr = ar - 1.0, ni = ai, den = lr * lr + li * li;
        const double cr = (nr * lr + ni * li) / den, ci = (ni * lr - nr * li) / den;
        ((f32x2*)(ws + OFF_A1))[item] = (f32x2){(float)ar, (float)ai};
#pragma unroll 1
        for (int i = 0; i < 4; ++i) { const double r2 = ar * ar - ai * ai, i2 = 2.0 * ar * ai; ar = r2; ai = i2; }
        ((f32x2*)(ws + OFF_A16))[item] = (f32x2){(float)ar, (float)ai};
#pragma unroll 1
        for (int i = 0; i < 2; ++i) { const double r2 = ar * ar - ai * ai, i2 = 2.0 * ar * ai; ar = r2; ai = i2; }
        ((f32x2*)(ws + OFF_A64))[item] = (f32x2){(float)ar, (float)ai};
        bf16_t* bm = (bf16_t*)(ws + OFF_BMT) + ((size_t)g * 128 + 64 * (n >> 5) + (n & 31)) * 16;
        const float* bre = p.in[7] + (size_t)item * 16; const float* bim = p.in[8] + (size_t)item * 16;
#pragma unroll
        for (int h = 0; h < 16; h += 2) {
            const double b0r = bre[h], b0i = bim[h], b1r = bre[h + 1], b1i = bim[h + 1];
            *(unsigned*)(bm + h) = cvt_pk_bf16((float)(cr * b0r - ci * b0i), (float)(cr * b1r - ci * b1i));
            *(unsigned*)(bm + 32 * 16 + h) = cvt_pk_bf16((float)(cr * b0i + ci * b0r), (float)(cr * b1i + ci * b1r));
        }
        bf16_t* cm = (bf16_t*)(ws + OFF_CMT) + (size_t)g * 16 * 128 + 2 * n;
#pragma unroll
        for (int h = 0; h < 16; ++h) *(unsigned*)(cm + h * 128) = cvt_pk_bf16(p.in[9][((size_t)g * 16 + h) * 64 + n], -p.in[10][((size_t)g * 16 + h) * 64 + n]);
    }
}
__device__ void p0_prologue(const Params& p, LAS unsigned char* lds, int tid, int bid, int G) {
    unsigned char* ws = p.ws;
    {
        const int cnt[6] = {896, 256, 128, 256, 1024, 1024};
        (void)cnt;
        for (int t = bid; t < 3584; t += G) {
            const float* W; bf16_t* Bt; int K, N, mode, lt; const float* ksc = nullptr;
            if (t < 896) { W = p.in[3]; Bt = (bf16_t*)(ws + OFF_WIN); K = 2048; N = 7168; mode = 1; lt = t; }
            else if (t < 1152) { W = p.in[12]; Bt = (bf16_t*)(ws + OFF_WGLU); K = 1024; N = 4096; mode = 2; lt = t - 896; }
            else if (t < 1280) { W = p.in[17]; Bt = (bf16_t*)(ws + OFF_WCO); K = 1024; N = 2048; mode = 0; lt = t - 1152; }
            else if (t < 1536) { W = p.in[18]; Bt = (bf16_t*)(ws + OFF_WOUT); K = 2048; N = 2048; mode = 0; lt = t - 1280; }
            else if (t < 2560) { W = p.in[20]; Bt = (bf16_t*)(ws + OFF_WFF1); K = 2048; N = 8192; mode = 0; lt = t - 1536; ksc = p.in[19]; }
            else { W = p.in[21]; Bt = (bf16_t*)(ws + OFF_WFF2); K = 8192; N = 2048; mode = 0; lt = t - 2560; }
            const int nnt = N / 256;
            convert_tile(W, Bt, K, N, mode, lt / nnt, lt % nnt, (LAS float*)lds, tid, ksc);
        }
    }
    {
        const int lane = tid & 63, gw = bid * 8 + (tid >> 6);
        bf16_t* A0 = (bf16_t*)(ws + OFF_A0);
        const float* g = p.in[2];
        for (int r = gw; r < MP; r += G * 8) {
            const float* src = nullptr;
            if (r < T) src = p.in[0] + (size_t)r * DM; else if (r >= T + 48 && r < T + 64) src = p.in[1] + (size_t)(r - T - 48) * DM;
            if (src) {
                f32x4 v[8]; float ss = 0.f;
#pragma unroll
                for (int i = 0; i < 8; ++i) { v[i] = __builtin_nontemporal_load((const f32x4*)(src + 4 * (lane + 64 * i))); ss += (v[i][0] * v[i][0] + v[i][1] * v[i][1]) + (v[i][2] * v[i][2] + v[i][3] * v[i][3]); }
                ss = wave_sum(ss);
                const float rstd = rsqrtf(ss * (1.0f / 2048.0f) + EPS);
#pragma unroll
                for (int i = 0; i < 8; ++i) { const f32x4 gg = *(const f32x4*)(g + 4 * (lane + 64 * i)); const f32x4 o = v[i] * rstd * gg;
                    u32x2 w; w.x = cvt_pk_bf16(o[0], o[1]); w.y = cvt_pk_bf16(o[2], o[3]); *(u32x2*)(A0 + (size_t)r * DM + 4 * (lane + 64 * i)) = w; }
            } else {
#pragma unroll
                for (int i = 0; i < 8; ++i) *(u32x2*)(A0 + (size_t)r * DM + 4 * (lane + 64 * i)) = (u32x2){0u, 0u};
            }
        }
    }
    if (bid == 0 && tid < 32) ((unsigned*)(ws + OFF_CNT))[tid * 64] = 0u;
    if (tid >= 448 && tid < 464) s5_constants(p, bid * 16 + (tid - 448), G * 16);
    if (bid == 0 && tid == 32) *(unsigned*)(ws + OFF_QCTR) = 0u;
}
__device__ __forceinline__ int tile_time(int i) { return 16 * ((i & 7) >> 2) + 4 * (i >> 3) + (i & 3); }
#define CMUL_ADD(or_, oi_, ar_, ai_, sr_, si_, br_, bi_) do { const float _r = fmaf((ar_), (sr_), fmaf(-(ai_), (si_), (br_))); const float _i = fmaf((ar_), (si_), fmaf((ai_), (sr_), (bi_))); or_ = _r; oi_ = _i; } while (0)
constexpr int SROW = 272;
template <int MODE>
__device__ __forceinline__ void ssm_task(unsigned char* ws, const float* dskip, int g, int q_lo, int q_hi, LAS unsigned char* wl, int lane) {
    const int j = lane & 31, hf = lane >> 5;
    const bf16_t* U = (const bf16_t*)(ws + OFF_U);
    f32x2* E = (f32x2*)(ws + OFF_E);
    bf16x8 bfrag[4];
#pragma unroll
    for (int ct = 0; ct < 4; ++ct) bfrag[ct] = *(const bf16x8*)((const bf16_t*)(ws + OFF_BMT) + ((size_t)g * 128 + ct * 32 + j) * 16 + 8 * hf);
    const f32x2 aL = ((const f32x2*)(ws + OFF_A1))[g * 64 + j], aH = ((const f32x2*)(ws + OFF_A1))[g * 64 + 32 + j];
    const f32x2 bL = ((const f32x2*)(ws + OFF_A16))[g * 64 + j], bH = ((const f32x2*)(ws + OFF_A16))[g * 64 + 32 + j];
    const f32x2 cL = ((const f32x2*)(ws + OFF_A64))[g * 64 + j], cH = ((const f32x2*)(ws + OFF_A64))[g * 64 + 32 + j];
    bf16x8 cfrag[4]; f32x4 dsk = {0.f, 0.f, 0.f, 0.f};
    if (MODE == 1) {
#pragma unroll
        for (int ks = 0; ks < 4; ++ks) cfrag[ks] = *(const bf16x8*)((const bf16_t*)(ws + OFF_CMT) + ((size_t)g * 16 + (lane & 15)) * 128 + 32 * ks + 8 * (lane >> 4));
        dsk = *(const f32x4*)(dskip + 16 * g + 4 * (lane >> 4));
    }
    f32x2 sL = {0.f, 0.f}, sH = {0.f, 0.f};
#pragma unroll 1
    for (int q = q_lo; q < q_hi; ++q) {
        const int row0 = q * 64;
        if (MODE == 1) {
        if (q == q_lo) {
            const int b = q >> 5, c = q & 31;
            sL = E[((size_t)128 * 64 + g) * 64 + j]; sH = E[((size_t)128 * 64 + g) * 64 + 32 + j];
#pragma unroll 1
            for (int cp = 0; cp < c; cp += 4) { f32x2 eL[4], eH[4];
#pragma unroll
                for (int u4 = 0; u4 < 4; ++u4) { eL[u4] = E[((size_t)(b * 32 + cp + u4) * 64 + g) * 64 + j]; eH[u4] = E[((size_t)(b * 32 + cp + u4) * 64 + g) * 64 + 32 + j]; }
#pragma unroll
                for (int u4 = 0; u4 < 4; ++u4) { CMUL_ADD(sL.x, sL.y, cL.x, cL.y, sL.x, sL.y, eL[u4].x, eL[u4].y); CMUL_ADD(sH.x, sH.y, cH.x, cH.y, sH.x, sH.y, eH[u4].x, eH[u4].y); } }
        }
        }
        f32x16 acc[2][4];
#pragma unroll
        for (int mt = 0; mt < 2; ++mt) {
            const bf16x8 af = *(const bf16x8*)(U + (size_t)(row0 + 32 * mt + tile_time(j)) * DS + 16 * g + 8 * hf);
#pragma unroll
            for (int ct = 0; ct < 4; ++ct) { f32x16 z;
#pragma unroll
                for (int r = 0; r < 16; ++r) z[r] = 0.f;
                acc[mt][ct] = __builtin_amdgcn_mfma_f32_32x32x16_bf16(af, bfrag[ct], z, 0, 0, 0); }
            asm volatile("" :: "v"(af), "v"(acc[mt][0]), "v"(acc[mt][1]), "v"(acc[mt][2]), "v"(acc[mt][3]));
        }
        float eLr[2], eLi[2], eHr[2], eHi[2];
#pragma unroll
        for (int mt = 0; mt < 2; ++mt) { float sr = 0.f, si = 0.f, tr = 0.f, ti = 0.f;
#pragma unroll
            for (int r = 0; r < 16; ++r) { CMUL_ADD(sr, si, aL.x, aL.y, sr, si, acc[mt][0][r], acc[mt][1][r]); CMUL_ADD(tr, ti, aH.x, aH.y, tr, ti, acc[mt][2][r], acc[mt][3][r]); }
            eLr[mt] = sr; eLi[mt] = si; eHr[mt] = tr; eHi[mt] = ti; }
        float pLr[2], pLi[2], pHr[2], pHi[2];
#pragma unroll
        for (int mt = 0; mt < 2; ++mt) { pLr[mt] = __shfl_xor(eLr[mt], 32); pLi[mt] = __shfl_xor(eLi[mt], 32); pHr[mt] = __shfl_xor(eHr[mt], 32); pHi[mt] = __shfl_xor(eHi[mt], 32); }
        if (MODE == 0) {
            float f0r, f0i, f1r, f1i, g0r, g0i, g1r, g1i;
            CMUL_ADD(f0r, f0i, bL.x, bL.y, pLr[0], pLi[0], eLr[0], eLi[0]); CMUL_ADD(f1r, f1i, bL.x, bL.y, pLr[1], pLi[1], eLr[1], eLi[1]);
            CMUL_ADD(g0r, g0i, bH.x, bH.y, pHr[0], pHi[0], eHr[0], eHi[0]); CMUL_ADD(g1r, g1i, bH.x, bH.y, pHr[1], pHi[1], eHr[1], eHi[1]);
            const float b2Lr = bL.x * bL.x - bL.y * bL.y, b2Li = 2.f * bL.x * bL.y, b2Hr = bH.x * bH.x - bH.y * bH.y, b2Hi = 2.f * bH.x * bH.y;
            float ELr, ELi, EHr, EHi;
            CMUL_ADD(ELr, ELi, b2Lr, b2Li, f0r, f0i, f1r, f1i); CMUL_ADD(EHr, EHi, b2Hr, b2Hi, g0r, g0i, g1r, g1i);
            if (hf == 1) { E[((size_t)q * 64 + g) * 64 + j] = (f32x2){ELr, ELi}; E[((size_t)q * 64 + g) * 64 + 32 + j] = (f32x2){EHr, EHi}; }
        } else {
            const float e0Lr = hf ? pLr[0] : eLr[0], e0Li = hf ? pLi[0] : eLi[0], e1Lr = hf ? eLr[0] : pLr[0], e1Li = hf ? eLi[0] : pLi[0], e2Lr = hf ? pLr[1] : eLr[1], e2Li = hf ? pLi[1] : eLi[1];
            const float e0Hr = hf ? pHr[0] : eHr[0], e0Hi = hf ? pHi[0] : eHi[0], e1Hr = hf ? eHr[0] : pHr[0], e1Hi = hf ? eHi[0] : pHi[0], e2Hr = hf ? pHr[1] : eHr[1], e2Hi = hf ? pHi[1] : eHi[1];
            float i1Lr, i1Li, i2Lr, i2Li, i3Lr, i3Li, i1Hr, i1Hi, i2Hr, i2Hi, i3Hr, i3Hi;
            CMUL_ADD(i1Lr, i1Li, bL.x, bL.y, sL.x, sL.y, e0Lr, e0Li); CMUL_ADD(i2Lr, i2Li, bL.x, bL.y, i1Lr, i1Li, e1Lr, e1Li); CMUL_ADD(i3Lr, i3Li, bL.x, bL.y, i2Lr, i2Li, e2Lr, e2Li);
            CMUL_ADD(i1Hr, i1Hi, bH.x, bH.y, sH.x, sH.y, e0Hr, e0Hi); CMUL_ADD(i2Hr, i2Hi, bH.x, bH.y, i1Hr, i1Hi, e1Hr, e1Hi); CMUL_ADD(i3Hr, i3Hi, bH.x, bH.y, i2Hr, i2Hi, e2Hr, e2Hi);
            float inLr[2], inLi[2], inHr[2], inHi[2];
            inLr[0] = hf ? i1Lr : sL.x; inLi[0] = hf ? i1Li : sL.y; inLr[1] = hf ? i3Lr : i2Lr; inLi[1] = hf ? i3Li : i2Li;
            inHr[0] = hf ? i1Hr : sH.x; inHi[0] = hf ? i1Hi : sH.y; inHr[1] = hf ? i3Hr : i2Hr; inHi[1] = hf ? i3Hi : i2Hi;
#pragma unroll
            for (int mt = 0; mt < 2; ++mt) {
                float sr = inLr[mt], si = inLi[mt], tr = inHr[mt], ti = inHi[mt];
#pragma unroll
                for (int r = 0; r < 16; ++r) { CMUL_ADD(sr, si, aL.x, aL.y, sr, si, acc[mt][0][r], acc[mt][1][r]); CMUL_ADD(tr, ti, aH.x, aH.y, tr, ti, acc[mt][2][r], acc[mt][3][r]);
                    *(LAS unsigned*)(wl + (16 * hf + r) * SROW + 4 * j) = cvt_pk_bf16(sr, si);
                    *(LAS unsigned*)(wl + (16 * hf + r) * SROW + 4 * (32 + j)) = cvt_pk_bf16(tr, ti); }
                if (mt == 1) {
                    const float oLr = __shfl_xor(sr, 32), oLi = __shfl_xor(si, 32), oHr = __shfl_xor(tr, 32), oHi = __shfl_xor(ti, 32);
                    sL.x = hf ? sr : oLr; sL.y = hf ? si : oLi; sH.x = hf ? tr : oHr; sH.y = hf ? ti : oHi; }
                asm volatile("s_waitcnt lgkmcnt(0)" ::: "memory");
#pragma unroll
                for (int th = 0; th < 2; ++th) {
                    f32x4 y = {0.f, 0.f, 0.f, 0.f};
                    bf16x8 sf[4];
#pragma unroll
                    for (int ks = 0; ks < 4; ++ks) sf[ks] = *(const LAS bf16x8*)(wl + (16 * th + (lane & 15)) * SROW + 64 * ks + 16 * (lane >> 4));
#pragma unroll
                    for (int ks = 0; ks < 4; ++ks) y = __builtin_amdgcn_mfma_f32_16x16x32_bf16(cfrag[ks], sf[ks], y, 0, 0, 0);
                    asm volatile("" :: "v"(sf[0]), "v"(sf[1]), "v"(sf[2]), "v"(sf[3]), "v"(y));
                    const size_t row = (size_t)(row0 + 32 * mt + 16 * th + (lane & 15)); const int col = 16 * g + 4 * (lane >> 4);
                    const u32x2 uu = *(const u32x2*)(U + row * DS + col);
                    f32x4 v; v[0] = fmaf(dsk[0], bflo(uu.x), y[0]); v[1] = fmaf(dsk[1], bfhi(uu.x), y[1]); v[2] = fmaf(dsk[2], bflo(uu.y), y[2]); v[3] = fmaf(dsk[3], bfhi(uu.y), y[3]);
#pragma unroll
                    for (int r = 0; r < 4; ++r) { const float x = v[r]; v[r] = x * sigm(1.5957691216f * (x + 0.044715f * x * x * x)); }
                    u32x2 o; o.x = cvt_pk_bf16(v[0], v[1]); o.y = cvt_pk_bf16(v[2], v[3]);
                    *(u32x2*)((bf16_t*)(ws + OFF_Z) + row * DS + col) = o;
                }
                asm volatile("s_waitcnt lgkmcnt(0)" ::: "memory");
            }
        }
    }
}

__device__ __forceinline__ void conv_tile(const Params& p, int ti, LAS float* ol, int tid) {
    unsigned char* ws = p.ws;
    const bf16_t* Cg = (const bf16_t*)(ws + OFF_CG);
    const int b = ti >> 7, l0 = (ti & 127) * 16, ch = 2 * tid;
    unsigned d[46];
#pragma unroll
    for (int jj = 0; jj < 46; ++jj) { const int o = l0 + jj - 30; const size_t row = (o >= 0) ? (size_t)(b * 2048 + o) : (size_t)(T + 64 + o); d[jj] = *(const unsigned*)(Cg + row * DS + ch); }
    f32x2 w[31];
#pragma unroll
    for (int j = 0; j < 31; ++j) w[j] = *(const f32x2*)(p.in[13] + j * DS + ch);
    const f32x2 bias = *(const f32x2*)(p.in[14] + ch);
#pragma unroll
    for (int tok = 0; tok < 16; ++tok) { float a0 = bias.x, a1 = bias.y;
#pragma unroll
        for (int j = 0; j < 31; ++j) { const unsigned x = d[tok + j]; a0 = fmaf(w[j].x, bflo(x), a0); a1 = fmaf(w[j].y, bfhi(x), a1); }
        *(LAS f32x2*)(ol + tok * DS + ch) = (f32x2){a0, a1}; }
    __syncthreads();
    const int wv = tid >> 6, lane = tid & 63;
#pragma unroll
    for (int tt = 0; tt < 2; ++tt) { const int tok = 2 * wv + tt; const size_t row = (size_t)(b * 2048 + l0 + tok);
        f32x4 v[4]; float s = 0.f;
#pragma unroll
        for (int i = 0; i < 4; ++i) { v[i] = *(const LAS f32x4*)(ol + tok * DS + 4 * (lane + 64 * i)); s += (v[i][0] + v[i][1]) + (v[i][2] + v[i][3]); }
        const float mean = wave_sum(s) * (1.0f / 1024.0f); float q = 0.f;
#pragma unroll
        for (int i = 0; i < 4; ++i) { v[i] = v[i] - mean; q += (v[i][0] * v[i][0] + v[i][1] * v[i][1]) + (v[i][2] * v[i][2] + v[i][3] * v[i][3]); }
        const float rstd = rsqrtf(wave_sum(q) * (1.0f / 1024.0f) + EPS);
#pragma unroll
        for (int i = 0; i < 4; ++i) { const int col = 4 * (lane + 64 * i); const f32x4 gg = *(const f32x4*)(p.in[15] + col), bb = *(const f32x4*)(p.in[16] + col);
            f32x4 y = v[i] * rstd * gg + bb;
#pragma unroll
            for (int r = 0; r < 4; ++r) y[r] = y[r] * sigm(y[r]);
            u32x2 o; o.x = cvt_pk_bf16(y[0], y[1]); o.y = cvt_pk_bf16(y[2], y[3]);
            *(u32x2*)((bf16_t*)(ws + OFF_CS) + row * DS + col) = o; }
    }
    __syncthreads();
}

#define XB_TMO      128
#define XB_XCNT(j)  (256  + 64 * (j))
#define XB_XSUB(j)  (1280 + 64 * (j))
#define XB_XGEN(j)  (2304 + 64 * (j))
#define XB_TOP      3328
#define XB_TOPGEN   3392
#define XCD_BAR_WORDS 3456
#define XB_SPIN_CAP (1u << 18)
__device__ __forceinline__ unsigned xb_ld(unsigned* p)              { return __hip_atomic_load(p, __ATOMIC_RELAXED, __HIP_MEMORY_SCOPE_AGENT); }
__device__ __forceinline__ unsigned xb_add(unsigned* p, unsigned v) { return __hip_atomic_fetch_add(p, v, __ATOMIC_RELAXED, __HIP_MEMORY_SCOPE_AGENT); }
__device__ __forceinline__ unsigned xb_xcc_id() { return (unsigned)__builtin_amdgcn_s_getreg((3 << 11) | 20) & 0xFu; }
#define XB_SPIN(cond, bar) do { unsigned _sp = 0; while (cond) { __builtin_amdgcn_s_sleep(1); \
    if ((++_sp & 255u) == 0u) { if (xb_ld(&(bar)[XB_TMO])) break; if (_sp > XB_SPIN_CAP) { atomicAdd(&(bar)[XB_TMO], 1u); break; } } } } while (0)

struct XcdBarrier {
    unsigned* bar; unsigned x;
    volatile LAS unsigned* st;
};

__device__ __forceinline__ XcdBarrier xcd_barrier_post(unsigned* bar, volatile LAS unsigned* st) {
    XcdBarrier b; b.bar = bar; b.x = xb_xcc_id(); b.st = st;
    if (threadIdx.x == 0) (void)xb_add(&bar[XB_XCNT(b.x)], 1u);
    return b;
}
__device__ __forceinline__ void xcd_barrier_complete(unsigned* bar, unsigned x, unsigned& nloc, unsigned& nx) {
    const unsigned G = gridDim.x * gridDim.y * gridDim.z;
    unsigned sum, cnt, mine, sp = 0u;
    for (;;) {
        sum = 0u; cnt = 0u; mine = 0u;
#pragma unroll
        for (unsigned j = 0; j < 16; ++j) { const unsigned c = xb_ld(&bar[XB_XCNT(j)]); sum += c; cnt += (c > 0u) ? 1u : 0u; mine = (j == x) ? c : mine; }
        if (sum == G) break;
        __builtin_amdgcn_s_sleep(1);
        if ((++sp & 255u) == 0u) { if (xb_ld(&bar[XB_TMO])) break; if (sp > XB_SPIN_CAP) { atomicAdd(&bar[XB_TMO], 1u); break; } }
    }
    nloc = mine > 0u ? mine : 1u; nx = cnt > 0u ? cnt : 1u;
}

__device__ __forceinline__ void xcd_barrier(const XcdBarrier& b) {
    asm volatile("s_waitcnt vmcnt(0)" ::: "memory");
    __syncthreads();
    if (threadIdx.x == 0) {
        unsigned* bar = b.bar;
        __builtin_amdgcn_s_waitcnt(0);
        unsigned nloc = b.st[0], nx = b.st[1];
        if (nloc == 0u) { xcd_barrier_complete(bar, b.x, nloc, nx); b.st[0] = nloc; b.st[1] = nx; }
        const unsigned old = xb_add(&bar[XB_XSUB(b.x)], 1u);
        const unsigned gen = old / nloc;
        if (old + 1u == (gen + 1u) * nloc) {
            __builtin_amdgcn_fence(__ATOMIC_RELEASE, "agent");
            asm volatile("s_waitcnt vmcnt(0)" ::: "memory");
            const unsigned og = xb_add(&bar[XB_TOP], 1u);
            const unsigned tg = og / nx;
            if (og + 1u == (tg + 1u) * nx) xb_add(&bar[XB_TOPGEN], 1u);
            else XB_SPIN(xb_ld(&bar[XB_TOPGEN]) == tg, bar);
            __builtin_amdgcn_fence(__ATOMIC_ACQUIRE, "agent");
            xb_add(&bar[XB_XGEN(b.x)], 1u);
            asm volatile("s_waitcnt vmcnt(0)" ::: "memory");
        } else {
            XB_SPIN(xb_ld(&bar[XB_XGEN(b.x)]) == gen, bar);
            __builtin_amdgcn_fence(__ATOMIC_ACQUIRE, "agent");
            asm volatile("s_waitcnt vmcnt(0)" ::: "memory");
        }
    }
    __syncthreads();
}

__global__ void __launch_bounds__(512, 2) fwd_kernel(Params p) {
    extern __shared__ __attribute__((aligned(16))) unsigned char lds_raw[];
    LAS unsigned char* lds = (LAS unsigned char*)lds_raw;
    const int tid = threadIdx.x, bid = blockIdx.x, G = gridDim.x, wave = __builtin_amdgcn_readfirstlane(tid >> 6), lane = tid & 63;
    unsigned char* ws = p.ws;
    const int lo = p.ph_lo, hi = p.ph_hi;
#define IN(k) (lo <= (k) && (k) < hi)
    if (hi > 1000) cg::this_grid().sync();
    volatile LAS unsigned* xst = (volatile LAS unsigned*)(lds + LDS_MAIN);
    if (tid == 0) { xst[0] = 0u; xst[1] = 0u; }
    __syncthreads();
    const XcdBarrier xbar = xcd_barrier_post((unsigned*)(ws + OFF_BAR), xst);
#define SEAM(k) do { if (IN(k) && IN((k) + 1)) xcd_barrier(xbar); } while (0)
    if (IN(0)) p0_prologue(p, lds, tid, bid, G);
    SEAM(0);
    if (IN(1)) {
        pg8::Gemm g{(const bf16_t*)(ws + OFF_A0), (const bf16_t*)(ws + OFF_WIN), T, NIN, DM}; Order1 S; S.init1(G, bid);
        Epi1 E{(bf16_t*)(ws + OFF_U), (bf16_t*)(ws + OFF_CG), (bf16_t*)(ws + OFF_SG)};
        pg8::gemm_phase<Epi1, Order1>(lds, g, S, E);
    }
    SEAM(1);
    if (IN(2)) {
        if (G == 256) {
            if (bid < 140) {
                pg8::Gemm g{(const bf16_t*)(ws + OFF_A0), (const bf16_t*)(ws + OFF_WIN), T, NIN, DM}; DeferredOrder S{bid};
                Epi1 E{(bf16_t*)(ws + OFF_U), (bf16_t*)(ws + OFF_CG), (bf16_t*)(ws + OFF_SG)};
                pg8::gemm_phase<Epi1, DeferredOrder>(lds, g, S, E);
            }
            volatile LAS unsigned* qw = (volatile LAS unsigned*)(lds + LDS_MAIN + 8);
            for (;;) {
                __syncthreads();
                if (tid == 0) *qw = __hip_atomic_fetch_add((unsigned*)(ws + OFF_QCTR), 1u, __ATOMIC_RELAXED, __HIP_MEMORY_SCOPE_AGENT);
                __syncthreads();
                const int item = (int)*qw;
                if (item >= 264 + 512) break;
                if (item < 264) { const int go = item & 7, cs = item >> 3; const int qh = (cs * 4 + 4 < 129) ? cs * 4 + 4 : 129;
                    ssm_task<0>(ws, p.in[11], go * 8 + wave, cs * 4, qh, lds + wave * (32 * SROW), lane); }
                else conv_tile(p, item - 264, (LAS float*)lds, tid);
            }
        } else {
            for (int task = bid; task < 33 * 8; task += G) { const int go = task & 7, cs = task >> 3; const int qh = (cs * 4 + 4 < 129) ? cs * 4 + 4 : 129;
                ssm_task<0>(ws, p.in[11], go * 8 + wave, cs * 4, qh, lds + wave * (32 * SROW), lane); }
            __syncthreads();
            for (int ti = bid; ti < 512; ti += G) conv_tile(p, ti, (LAS float*)lds, tid);
        }
    }
    SEAM(2);
    if (IN(3)) {
        for (int task = bid; task < 32 * 8; task += G) { const int go = task & 7, cs = task >> 3;
            ssm_task<1>(ws, p.in[11], go * 8 + wave, cs * 4, cs * 4 + 4, lds + wave * (32 * SROW), lane); }
        __syncthreads();
        if (G != 256) {
            pg8::Gemm g{(const bf16_t*)(ws + OFF_CS), (const bf16_t*)(ws + OFF_WCO), T, DM, DS}; pg8::StaticOrder S; S.init(T, DM, G, bid);
            EpiCo E{(const bf16_t*)(ws + OFF_SG), (bf16_t*)(ws + OFF_TB)};
            pg8::gemm_phase<EpiCo, pg8::StaticOrder>(lds, g, S, E);
        }
    }
    SEAM(3);
    if (IN(4)) {
        if (G == 256) {
            pg8::Gemm g{(const bf16_t*)(ws + OFF_CS), (const bf16_t*)(ws + OFF_WCO), T, DM, DS, (const bf16_t*)(ws + OFF_Z), (const bf16_t*)(ws + OFF_WGLU)};
            TripleOrder S; S.init(G, bid);
            EpiCoGlu E{EpiCo{(const bf16_t*)(ws + OFF_SG), (bf16_t*)(ws + OFF_TB)}, EpiGlu{(const bf16_t*)(ws + OFF_SG), (const bf16_t*)(ws + OFF_TB), (bf16_t*)(ws + OFF_MG)}};
            pg8::gemm_phase<EpiCoGlu, TripleOrder, true>(lds, g, S, E);
        } else {
            pg8::Gemm g{(const bf16_t*)(ws + OFF_Z), (const bf16_t*)(ws + OFF_WGLU), T, 4096, DS}; pg8::StaticOrder S; S.init(T, 4096, G, bid);
            EpiGlu E{(const bf16_t*)(ws + OFF_SG), (const bf16_t*)(ws + OFF_TB), (bf16_t*)(ws + OFF_MG)};
            pg8::gemm_phase<EpiGlu, pg8::StaticOrder>(lds, g, S, E);
        }
    }
    SEAM(4);
    if (IN(5)) {
        pg8::Gemm g{(const bf16_t*)(ws + OFF_MG), (const bf16_t*)(ws + OFF_WOUT), T, DM, DM}; pg8::StaticOrder S; S.init(T, DM, G, bid);
        EpiOut E{p.in[0], (bf16_t*)(ws + OFF_HG), (float*)(ws + OFF_SS2)};
        pg8::gemm_phase<EpiOut, pg8::StaticOrder>(lds, g, S, E);
    }
    SEAM(5);
    if (IN(6)) {
        pg8::Gemm g{(const bf16_t*)(ws + OFF_HG), (const bf16_t*)(ws + OFF_WFF1), T, DFF, DM}; pg8::StaticOrder S; S.init(T, DFF, G, bid);
        EpiFf1 E{(bf16_t*)(ws + OFF_ACT)};
        pg8::gemm_phase<EpiFf1, pg8::StaticOrder>(lds, g, S, E);
    }
    SEAM(6);
    if (IN(7)) {
        pg8::Gemm g{(const bf16_t*)(ws + OFF_ACT), (const bf16_t*)(ws + OFF_WFF2), T, DM, DFF}; pg8::StaticOrder S; S.init(T, DM, G, bid);
        if (G == 256) {
            EpiFf2N E{(const bf16_t*)(ws + OFF_HG), p.out, (const float*)(ws + OFF_SS2), (float*)(ws + OFF_SS3), (unsigned*)(ws + OFF_CNT), p.in[22]};
            pg8::gemm_phase<EpiFf2N, pg8::StaticOrder, false, true>(lds, g, S, E);
        } else {
            EpiFf2 E{(const bf16_t*)(ws + OFF_HG), p.out, (const float*)(ws + OFF_SS2), (float*)(ws + OFF_SS3)};
            pg8::gemm_phase<EpiFf2, pg8::StaticOrder, false, true>(lds, g, S, E);
        }
    }
    if (G != 256) SEAM(7);
    if (IN(8) && G != 256) {
        const float* SS3 = (const float*)(ws + OFF_SS3); const float* gf = p.in[22];
        for (int row = bid * 8 + wave; row < T; row += G * 8) {
            float t = SS3[(size_t)row * 32 + (lane & 31)];
            t += __shfl_xor(t, 16); t += __shfl_xor(t, 8); t += __shfl_xor(t, 4); t += __shfl_xor(t, 2); t += __shfl_xor(t, 1);
            const float rstd = rsqrtf(t * (1.0f / 2048.0f) + EPS);
            float* o = p.out + (size_t)row * DM;
#pragma unroll
            for (int i = 0; i < 8; ++i) { const int col = 4 * (lane + 64 * i); const f32x4 v = *(const f32x4*)(o + col), gg = *(const f32x4*)(gf + col); *(f32x4*)(o + col) = v * rstd * gg; }
        }
    }
#undef IN
#undef SEAM
}

extern "C" void kernel_launch(void* const* d_in, const int* in_sizes, int n_in, void* d_out, int out_size, void* d_ws, size_t ws_size, hipStream_t stream) {
    static int grid = 0;
    if (grid == 0) {
        if (n_in != 23 || out_size != T * DM || ws_size < WS_END) { fprintf(stderr, "kernel_launch: unexpected shapes (n_in %d out %d ws %zu need %zu)\n", n_in, out_size, ws_size, (size_t)WS_END); grid = -1; return; }
        int dev = 0, cus = 0, per_cu = 0;
        (void)hipGetDevice(&dev); (void)hipDeviceGetAttribute(&cus, hipDeviceAttributeMultiprocessorCount, dev);
        if (hipFuncSetAttribute((const void*)fwd_kernel, hipFuncAttributeMaxDynamicSharedMemorySize, LDS_BYTES) != hipSuccess) { fprintf(stderr, "kernel_launch: hipFuncSetAttribute failed\n"); grid = -1; return; }
        if (hipOccupancyMaxActiveBlocksPerMultiprocessor(&per_cu, (const void*)fwd_kernel, 512, LDS_BYTES) != hipSuccess || per_cu < 1) { fprintf(stderr, "kernel_launch: occupancy query says %d blocks/CU\n", per_cu); (void)hipGetLastError(); per_cu = 1; }
        grid = cus;
        if (grid > cus * per_cu) grid = cus * per_cu;
    }
    if (grid < 0) return;
    Params p{};
    for (int i = 0; i < 23; ++i) p.in[i] = (const float*)d_in[i];
    p.out = (float*)d_out; p.ws = (unsigned char*)d_ws;
    p.ph_lo = 0; p.ph_hi = 9;
    (void)hipMemsetAsync((unsigned char*)d_ws + OFF_BAR, 0, XCD_BAR_WORDS * 4, stream);
    void* args[] = {&p};
    hipError_t e = hipLaunchCooperativeKernel((const void*)fwd_kernel, dim3(grid), dim3(512), args, LDS_BYTES, stream);
    if (e != hipSuccess) fprintf(stderr, "cooperative launch failed: %s (grid %d)\n", hipGetErrorString(e), grid);
}
```

```cpp
#include <hip/hip_runtime.h>
#include <hip/hip_cooperative_groups.h>
#include <cstdio>
namespace cg = cooperative_groups;
namespace pg8 {
#define PG8_LAS __attribute__((address_space(3)))
typedef unsigned short bf16_t;
typedef short bf16x8 __attribute__((ext_vector_type(8)));
typedef float f32x4 __attribute__((ext_vector_type(4)));
typedef unsigned u32x4 __attribute__((ext_vector_type(4)));
constexpr int BM = 256, BK = 64, HALF = 128, HTB = HALF * BK * 2  , STAGE_BYTES = 8 * HTB, NXCD = 8, WGM = 8;

__host__ __device__ __forceinline__ int lds_byte(int r, int c) { const int st = (r >> 4) * 2 + (c >> 5), rr = r & 15, cc = c & 31, ob = rr * 64 + cc * 2; return st * 1024 + (ob ^ (((ob >> 9) & 1) << 5)); }
__host__ __device__ __forceinline__ void stage_rc(int b, int& R, int& C) { const int st = b / 1024, sb = b % 1024, swz = sb ^ (((sb >> 9) & 1) << 5); R = (st >> 1) * 16 + swz / 64; C = (st & 1) * 32 + (swz % 64) / 2; }
__host__ __device__ __forceinline__ int perm32(int rho) { const int n = rho >> 4, i = rho & 15; return 8 * (i >> 2) + 4 * n + (i & 3); }

struct Unit { int pm, pn, kind; };
struct Gemm { const bf16_t* A; const bf16_t* Bt; int M, N, K; const bf16_t* A2; const bf16_t* Bt2; };

struct StaticOrder {
    int nM, nN, nwg, G, c;
    __host__ __device__ void init(int M, int N, int G_, int c_) { nM = M / BM; nN = N / BM; nwg = nM * nN; G = G_; c = c_; }
    __host__ __device__ bool next(int i, Unit& u) const {
        const long L = (long)i * G + c; if (L >= nwg) return false;
        int wgid = (int)L; { const int q = nwg / NXCD, r = nwg % NXCD, xcd = wgid % NXCD, off = wgid / NXCD; wgid = (xcd < r ? xcd * (q + 1) : r * (q + 1) + (xcd - r) * q) + off; }
        const int nig = WGM * nN, gid = wgid / nig, fm = gid * WGM, gsz = (nM - fm) < WGM ? (nM - fm) : WGM;
        u.pm = fm + ((wgid % nig) % gsz); u.pn = (wgid % nig) / gsz; return true;
    }
    __device__ __forceinline__ void a_ready(const Unit&) const {}
    __device__ __forceinline__ void done(const Unit&) const {}
};
typedef float f32x2c __attribute__((ext_vector_type(2)));
typedef __bf16 bf16x2c __attribute__((ext_vector_type(2)));
__device__ __forceinline__ unsigned cvt_pk_bf16(float lo, float hi) { const f32x2c v = {lo, hi}; return __builtin_bit_cast(unsigned, __builtin_convertvector(v, bf16x2c)); }

template <class Epi, class Sched, bool HETERO = false, bool ATILED = false>
__device__ __forceinline__ void gemm_phase(PG8_LAS unsigned char* lds, const Gemm g, const Sched& S, const Epi& E) {
    const int tid = threadIdx.x, wid = __builtin_amdgcn_readfirstlane(tid >> 6), lane = tid & 63, wr = wid >> 2, wc = wid & 3, fr = lane & 15, fq = lane >> 4;
    const int K = g.K, nt = K / BK;
    unsigned voffA[2], voffB[2];
#pragma unroll
    for (int i = 0; i < 2; ++i) { int R, C; stage_rc(tid * 16 + i * 8192, R, C); const int Rb = Epi::PERM ? ((R & ~31) + perm32(R & 31)) : R;
        voffA[i] = (unsigned)(R * (ATILED ? BK : K) + C) * 2u; voffB[i] = (unsigned)(Rb * BK + C) * 2u; }
    const size_t kstep = ATILED ? (size_t)BM * BK * 2 : (size_t)(BK * 2);
    const size_t hstep = ATILED ? (size_t)HALF * BK * 2 : (size_t)HALF * K * 2;
    const size_t tstep = (size_t)BM * K * 2;
    const size_t kstepB = (size_t)BM * BK * 2, hstepB = (size_t)HALF * BK * 2, tstepB = (size_t)nt * kstepB;
    const unsigned ldsw = (unsigned)wid * 1024u;
    const int aoff = lds_byte(wr * 64 + fr, fq * 8), boff = lds_byte(wc * 32 + fr, fq * 8);
#define PG8_SA(b, h) (((b) * 2 + (h)) * HTB)
#define PG8_SB(b, h) ((4 + (b) * 2 + (h)) * HTB)
#define PG8_STAGE(bufoff, gbase, voff) do { _Pragma("unroll") for (int _i = 0; _i < 2; ++_i) \
        __builtin_amdgcn_global_load_lds((const unsigned*)((const char*)(gbase) + (voff)[_i]), (PG8_LAS unsigned*)(lds + (bufoff) + ldsw + _i * 8192), 16, 0, 0); } while (0)
#define PG8_LDA(dst, b, h) do { _Pragma("unroll") for (int m = 0; m < 4; ++m) _Pragma("unroll") for (int k = 0; k < 2; ++k) dst[m][k] = *(const PG8_LAS bf16x8*)(lds + PG8_SA(b, h) + aoff + m * 2048 + k * 1024); } while (0)
#define PG8_LDB(dst, b, h) do { _Pragma("unroll") for (int n = 0; n < 2; ++n) _Pragma("unroll") for (int k = 0; k < 2; ++k) dst[n][k] = *(const PG8_LAS bf16x8*)(lds + PG8_SB(b, h) + boff + n * 2048 + k * 1024); } while (0)
#define PG8_MMA(ai, bj, At, Bt) do { __builtin_amdgcn_s_setprio(1); _Pragma("unroll") for (int m = 0; m < 4; ++m) _Pragma("unroll") for (int n = 0; n < 2; ++n) _Pragma("unroll") for (int k = 0; k < 2; ++k) \
        acc[ai][bj][m][n] = __builtin_amdgcn_mfma_f32_16x16x32_bf16(Bt[n][k], At[m][k], acc[ai][bj][m][n], 0, 0, 0); __builtin_amdgcn_s_setprio(0); } while (0)
#define PG8_WAIT_V(n) asm volatile("s_waitcnt vmcnt(" #n ")" ::: "memory")
#define PG8_WAIT_L(n) asm volatile("s_waitcnt lgkmcnt(" #n ")" ::: "memory")
#define PG8_BAR __builtin_amdgcn_s_barrier()
#define PG8_SCHED __builtin_amdgcn_sched_barrier(0)
    Unit cur, nxt; int ui = 0;
    if (!S.next(0, cur)) return;
    f32x4 acc[2][2][4][2];
#pragma unroll
    for (int a = 0; a < 2; ++a)
#pragma unroll
        for (int b = 0; b < 2; ++b)
#pragma unroll
            for (int m = 0; m < 4; ++m)
#pragma unroll
                for (int n = 0; n < 2; ++n) acc[a][b][m][n] = (f32x4){0.f, 0.f, 0.f, 0.f};
    bf16x8 At[4][2], B0[2][2], B1[2][2];
    const char* cA = (const char*)((HETERO && cur.kind) ? g.A2 : g.A) + (size_t)cur.pm * tstep; const char* cB = (const char*)((HETERO && cur.kind) ? g.Bt2 : g.Bt) + (size_t)cur.pn * tstepB;
    S.a_ready(cur);
    PG8_STAGE(PG8_SB(0, 0), cB, voffB); PG8_STAGE(PG8_SA(0, 0), cA, voffA); PG8_STAGE(PG8_SB(0, 1), cB + hstepB, voffB); PG8_STAGE(PG8_SA(0, 1), cA + hstep, voffA);
    if (wr == 1) PG8_BAR;
    PG8_WAIT_V(4); PG8_BAR;
    PG8_STAGE(PG8_SB(1, 0), cB + kstepB, voffB); PG8_STAGE(PG8_SA(1, 0), cA + kstep, voffA); PG8_STAGE(PG8_SB(1, 1), cB + hstepB + kstepB, voffB);
    PG8_WAIT_V(6); PG8_BAR;
    for (;;) {
        const bool has_next = S.next(ui + 1, nxt);
        const char* nA = has_next ? (const char*)((HETERO && nxt.kind) ? g.A2 : g.A) + (size_t)nxt.pm * tstep : cA; const char* nB = has_next ? (const char*)((HETERO && nxt.kind) ? g.Bt2 : g.Bt) + (size_t)nxt.pn * tstepB : cB;
        for (int t = 0; t < nt; t += 2) {
            const bool last = (t == nt - 2);
            const char* a1 = cA + (size_t)(t + 1) * kstep;
            const char* a2 = last ? nA : cA + (size_t)(t + 2) * kstep; const char* b2 = last ? nB : cB + (size_t)(t + 2) * kstepB;
            const char* a3 = a2 + kstep; const char* b3 = b2 + kstepB;
            if (last && has_next) S.a_ready(nxt);
            PG8_LDB(B0, 0, 0); PG8_SCHED; PG8_LDA(At, 0, 0); PG8_STAGE(PG8_SA(1, 1), a1 + hstep, voffA);
            PG8_WAIT_L(8); PG8_BAR; PG8_WAIT_L(0); PG8_MMA(0, 0, At, B0); PG8_BAR; PG8_SCHED;
            PG8_LDB(B1, 0, 1); PG8_STAGE(PG8_SB(0, 0), b2, voffB);
            PG8_BAR; PG8_WAIT_L(0); PG8_MMA(0, 1, At, B1); PG8_BAR;
            PG8_LDA(At, 0, 1); PG8_STAGE(PG8_SA(0, 0), a2, voffA);
            PG8_BAR; PG8_WAIT_L(0); PG8_MMA(1, 0, At, B0); PG8_BAR; PG8_SCHED;
            PG8_STAGE(PG8_SB(0, 1), b2 + hstepB, voffB);
            PG8_WAIT_V(6); PG8_BAR; PG8_MMA(1, 1, At, B1); PG8_BAR;
            PG8_LDB(B0, 1, 0); PG8_SCHED; PG8_LDA(At, 1, 0); PG8_STAGE(PG8_SA(0, 1), a2 + hstep, voffA);
            PG8_WAIT_L(8); PG8_BAR; PG8_WAIT_L(0); PG8_MMA(0, 0, At, B0); PG8_BAR; PG8_SCHED;
            PG8_LDB(B1, 1, 1); PG8_STAGE(PG8_SB(1, 0), b3, voffB);
            PG8_BAR; PG8_WAIT_L(0); PG8_MMA(0, 1, At, B1); PG8_BAR;
            PG8_LDA(At, 1, 1); PG8_STAGE(PG8_SA(1, 0), a3, voffA);
            PG8_BAR; PG8_WAIT_L(0); PG8_MMA(1, 0, At, B0); PG8_BAR; PG8_SCHED;
            PG8_STAGE(PG8_SB(1, 1), b3 + hstepB, voffB);
            PG8_WAIT_V(6); PG8_BAR; PG8_MMA(1, 1, At, B1); PG8_BAR;
        }
        if constexpr (!Epi::AFTER_DRAIN) { E(acc, cur, wr, wc, fr, fq); S.done(cur); }
        if (!has_next) break;
#pragma unroll
        for (int a = 0; a < 2; ++a)
#pragma unroll
            for (int b = 0; b < 2; ++b)
#pragma unroll
                for (int m = 0; m < 4; ++m)
#pragma unroll
                    for (int n = 0; n < 2; ++n) acc[a][b][m][n] = (f32x4){0.f, 0.f, 0.f, 0.f};
        cur = nxt; cA = nA; cB = nB; ++ui;
    }
    PG8_WAIT_V(0);
    if (wr == 0) PG8_BAR;
    PG8_BAR;
    if constexpr (Epi::AFTER_DRAIN) { E.fused(acc, cur, wr, wc, fr, fq, lds, wid, lane); S.done(cur); }
#undef PG8_SA
#undef PG8_SB
#undef PG8_STAGE
#undef PG8_LDA
#undef PG8_LDB
#undef PG8_MMA
#undef PG8_WAIT_V
#undef PG8_WAIT_L
#undef PG8_BAR
#undef PG8_SCHED
}
}

using pg8::bf16_t; using pg8::bf16x8; using pg8::f32x4; using pg8::u32x4; using pg8::Unit; using pg8::cvt_pk_bf16;
#define LAS __attribute__((address_space(3)))
typedef float f32x16 __attribute__((ext_vector_type(16)));
typedef float f32x2 __attribute__((ext_vector_type(2)));
typedef unsigned u32x2 __attribute__((ext_vector_type(2)));

constexpr int T = 8192, DM = 2048, MP = 8448, NIN = 7168, DFF = 8192, DS = 1024;
constexpr float EPS = 1e-6f;
constexpr int LDS_MAIN = 131072, LDS_BYTES = LDS_MAIN + 16;
constexpr size_t OFF_WFF1 = 0, OFF_WFF2 = 33554432, OFF_WOUT = 67108864, OFF_WGLU = 75497472, OFF_WCO = 83886080, OFF_WIN = 88080384,
                 OFF_A0 = 117440512, OFF_CG = 152043520, OFF_U = 169345024, OFF_SG = 186646528, OFF_CS = 253755392, OFF_SMALL = 287309824;
constexpr size_t OFF_SS2 = OFF_SMALL, OFF_SS3 = OFF_SS2 + 1048576, OFF_A1 = OFF_SS3 + 1048576, OFF_A16 = OFF_A1 + 32768, OFF_A64 = OFF_A16 + 32768,
                 OFF_BMT = OFF_A64 + 32768, OFF_CMT = OFF_BMT + 262144, OFF_CNT = OFF_CMT + 262144, OFF_QCTR = OFF_CNT + 32 * 256, OFF_BAR = OFF_QCTR + 256, WS_END = OFF_BAR + 16384;
constexpr size_t OFF_E = OFF_WIN, OFF_Z = OFF_E + 4227072, OFF_TB = OFF_A0, OFF_MG = OFF_CG, OFF_HG = OFF_WIN, OFF_ACT = OFF_HG + 33554432;
static_assert(OFF_Z + 16777216 <= OFF_A0, "Z overlay");
static_assert(OFF_TB + 33554432 <= OFF_CG, "TB overlay");
static_assert(OFF_MG + 33554432 <= OFF_SG, "MG overlay");
static_assert(OFF_CS + 16777216 <= OFF_SMALL, "CS region");
static_assert(OFF_ACT + 134217728 <= OFF_SMALL, "ACT overlay");

struct Params { const float* in[23]; float* out; unsigned char* ws; int ph_lo, ph_hi; };

__device__ __forceinline__ float sigm(float x) { return __builtin_amdgcn_rcpf(1.0f + __expf(-x)); }
__device__ __forceinline__ size_t sgidx(int row, int col) { return ((size_t)(row >> 8) * 32 + (col >> 7)) * 32768 + (size_t)((row & 255) * 128 + (col & 127)); }
__device__ __forceinline__ size_t tbidx(int row, int col) { return ((size_t)(row >> 8) * 16 + (col >> 7)) * 32768 + (size_t)((row & 255) * 128 + (col & 127)); }
__device__ __forceinline__ float bflo(unsigned w) { return __uint_as_float(w << 16); }
__device__ __forceinline__ float bfhi(unsigned w) { return __uint_as_float(w & 0xffff0000u); }
__device__ __forceinline__ u32x4 pack8(f32x4 a, f32x4 b) { u32x4 w; w.x = cvt_pk_bf16(a[0], a[1]); w.y = cvt_pk_bf16(a[2], a[3]); w.z = cvt_pk_bf16(b[0], b[1]); w.w = cvt_pk_bf16(b[2], b[3]); return w; }
__device__ __forceinline__ void unpack8(u32x4 w, f32x4& a, f32x4& b) { a[0] = bflo(w.x); a[1] = bfhi(w.x); a[2] = bflo(w.y); a[3] = bfhi(w.y); b[0] = bflo(w.z); b[1] = bfhi(w.z); b[2] = bflo(w.w); b[3] = bfhi(w.w); }
__device__ __forceinline__ float wave_sum(float v) { v += __shfl_xor(v, 32); v += __shfl_xor(v, 16); v += __shfl_xor(v, 8); v += __shfl_xor(v, 4); v += __shfl_xor(v, 2); v += __shfl_xor(v, 1); return v; }

struct Epi1 {
    static constexpr bool PERM = true, AFTER_DRAIN = false;
    bf16_t* U; bf16_t* Cg; bf16_t* SG;
    __device__ __forceinline__ void operator()(const f32x4 (&acc)[2][2][4][2], const Unit& u, int wr, int wc, int fr, int fq) const {
        const int row0 = u.pm * 256 + wr * 64 + fr, cl = wc * 32 + 8 * fq;
        if (u.pn < 4) {
#pragma unroll
            for (int ai = 0; ai < 2; ++ai)
#pragma unroll
                for (int m = 0; m < 4; ++m) { bf16_t* rowp = U + (size_t)(row0 + ai * 128 + m * 16) * DS + u.pn * 256 + cl;
#pragma unroll
                    for (int bj = 0; bj < 2; ++bj) *(u32x4*)(rowp + bj * 128) = pack8(acc[ai][bj][m][0], acc[ai][bj][m][1]); }
        } else if (u.pn < 12) {
#pragma unroll
            for (int ai = 0; ai < 2; ++ai)
#pragma unroll
                for (int m = 0; m < 4; ++m) { bf16_t* rowp = Cg + (size_t)(row0 + ai * 128 + m * 16) * DS + (u.pn - 4) * 128 + cl;
                    f32x4 v0, v1;
#pragma unroll
                    for (int j = 0; j < 4; ++j) { v0[j] = acc[ai][0][m][0][j] * sigm(acc[ai][1][m][0][j]); v1[j] = acc[ai][0][m][1][j] * sigm(acc[ai][1][m][1][j]); }
                    *(u32x4*)rowp = pack8(v0, v1); }
        } else {
#pragma unroll
            for (int ai = 0; ai < 2; ++ai)
#pragma unroll
                for (int m = 0; m < 4; ++m) { const int srow = row0 + ai * 128 + m * 16, scol = (u.pn - 12) * 256 + cl;
#pragma unroll
                    for (int bj = 0; bj < 2; ++bj) { f32x4 v0, v1;
#pragma unroll
                        for (int j = 0; j < 4; ++j) { v0[j] = sigm(acc[ai][bj][m][0][j]); v1[j] = sigm(acc[ai][bj][m][1][j]); }
                        *(u32x4*)(SG + sgidx(srow, scol + bj * 128)) = pack8(v0, v1); } }
        }
    }
};
struct EpiCo {
    static constexpr bool PERM = true, AFTER_DRAIN = false;
    const bf16_t* SG; bf16_t* TB;
    __device__ __forceinline__ void operator()(const f32x4 (&acc)[2][2][4][2], const Unit& u, int wr, int wc, int fr, int fq) const {
        const int row0 = u.pm * 256 + wr * 64 + fr, cl = u.pn * 256 + wc * 32 + 8 * fq;
#pragma unroll
        for (int ai = 0; ai < 2; ++ai)
#pragma unroll
            for (int m = 0; m < 4; ++m) { const size_t row = (size_t)(row0 + ai * 128 + m * 16);
#pragma unroll
                for (int bj = 0; bj < 2; ++bj) { const u32x4 s = *(const u32x4*)(SG + sgidx((int)row, 2048 + cl + bj * 128)); f32x4 s0, s1; unpack8(s, s0, s1);
                    *(u32x4*)(TB + tbidx((int)row, cl + bj * 128)) = pack8(acc[ai][bj][m][0] * s0, acc[ai][bj][m][1] * s1); } }
    }
};
struct EpiGlu {
    static constexpr bool PERM = true, AFTER_DRAIN = false;
    const bf16_t* SG; const bf16_t* TB; bf16_t* MG;
    __device__ __forceinline__ void operator()(const f32x4 (&acc)[2][2][4][2], const Unit& u, int wr, int wc, int fr, int fq) const {
        const int row0 = u.pm * 256 + wr * 64 + fr, cl = u.pn * 128 + wc * 32 + 8 * fq;
#pragma unroll
        for (int ai = 0; ai < 2; ++ai)
#pragma unroll
            for (int m = 0; m < 4; ++m) { const size_t row = (size_t)(row0 + ai * 128 + m * 16);
                const u32x4 s = *(const u32x4*)(SG + sgidx((int)row, cl)); const u32x4 t = *(const u32x4*)(TB + tbidx((int)row, cl));
                f32x4 s0, s1, t0, t1, v0, v1; unpack8(s, s0, s1); unpack8(t, t0, t1);
#pragma unroll
                for (int j = 0; j < 4; ++j) { v0[j] = s0[j] * acc[ai][0][m][0][j] * sigm(acc[ai][1][m][0][j]) + t0[j]; v1[j] = s1[j] * acc[ai][0][m][1][j] * sigm(acc[ai][1][m][1][j]) + t1[j]; }
                *(u32x4*)(MG + row * DM + cl) = pack8(v0, v1); }
    }
};
struct EpiOut {
    static constexpr bool PERM = true, AFTER_DRAIN = false;
    const float* X; bf16_t* H2B; float* SS;
    __device__ __forceinline__ void operator()(const f32x4 (&acc)[2][2][4][2], const Unit& u, int wr, int wc, int fr, int fq) const {
        const int row0 = u.pm * 256 + wr * 64 + fr, cl = u.pn * 256 + wc * 32 + 8 * fq;
#pragma unroll
        for (int ai = 0; ai < 2; ++ai)
#pragma unroll
            for (int m = 0; m < 4; ++m) { const size_t row = (size_t)(row0 + ai * 128 + m * 16); float ss = 0.f;
#pragma unroll
                for (int bj = 0; bj < 2; ++bj) { const size_t o = row * DM + cl + bj * 128;
                    const f32x4 h0 = __builtin_nontemporal_load((const f32x4*)(X + o)) + acc[ai][bj][m][0], h1 = __builtin_nontemporal_load((const f32x4*)(X + o + 4)) + acc[ai][bj][m][1];
                    ss += (h0[0] * h0[0] + h0[1] * h0[1]) + (h0[2] * h0[2] + h0[3] * h0[3]) + (h1[0] * h1[0] + h1[1] * h1[1]) + (h1[2] * h1[2] + h1[3] * h1[3]);
                    *(u32x4*)(H2B + o) = pack8(h0, h1); }
                ss += __shfl_xor(ss, 16); ss += __shfl_xor(ss, 32);
                if (fq == 0) SS[row * 32 + u.pn * 4 + wc] = ss;
                if (m & 1) asm volatile("" ::: "memory"); }
    }
};
struct EpiFf1 {
    static constexpr bool PERM = true, AFTER_DRAIN = false;
    bf16_t* ACT;
    __device__ __forceinline__ void operator()(const f32x4 (&acc)[2][2][4][2], const Unit& u, int wr, int wc, int fr, int fq) const {
        const int row0 = u.pm * 256 + wr * 64 + fr, cl = u.pn * 256 + wc * 32 + 8 * fq;
#pragma unroll
        for (int ai = 0; ai < 2; ++ai)
#pragma unroll
            for (int m = 0; m < 4; ++m) { const int row = row0 + ai * 128 + m * 16;
#pragma unroll
                for (int bj = 0; bj < 2; ++bj) { f32x4 v0, v1;
#pragma unroll
                    for (int j = 0; j < 4; ++j) { const float a = fmaxf(acc[ai][bj][m][0][j], 0.f), b = fmaxf(acc[ai][bj][m][1][j], 0.f); v0[j] = a * a; v1[j] = b * b; }
                    const int col = cl + bj * 128; *(u32x4*)(ACT + ((size_t)(row >> 8) * (DFF / 64) + (col >> 6)) * 16384 + (row & 255) * 64 + (col & 63)) = pack8(v0, v1); } }
    }
};
struct EpiFf2 {
    static constexpr bool PERM = true, AFTER_DRAIN = false;
    const bf16_t* H2B; float* H; const float* SS2; float* SS3;
    __device__ __forceinline__ void operator()(const f32x4 (&acc)[2][2][4][2], const Unit& u, int wr, int wc, int fr, int fq) const {
        const int row0 = u.pm * 256 + wr * 64 + fr, cl = u.pn * 256 + wc * 32 + 8 * fq;
#pragma unroll
        for (int ai = 0; ai < 2; ++ai)
#pragma unroll
            for (int m = 0; m < 4; ++m) { const size_t row = (size_t)(row0 + ai * 128 + m * 16);
                const f32x4 p0 = *(const f32x4*)(SS2 + row * 32 + fq * 8), p1 = *(const f32x4*)(SS2 + row * 32 + fq * 8 + 4);
                float t = ((p0[0] + p0[1]) + (p0[2] + p0[3])) + ((p1[0] + p1[1]) + (p1[2] + p1[3]));
                t += __shfl_xor(t, 16); t += __shfl_xor(t, 32);
                const float rs2 = 1.0f / (t * (1.0f / 2048.0f) + EPS); float ss = 0.f;
#pragma unroll
                for (int bj = 0; bj < 2; ++bj) { const size_t o = row * DM + cl + bj * 128;
                    f32x4 r0, r1; unpack8(*(const u32x4*)(H2B + o), r0, r1);
                    const f32x4 h0 = r0 + rs2 * acc[ai][bj][m][0], h1 = r1 + rs2 * acc[ai][bj][m][1];
                    *(f32x4*)(H + o) = h0; *(f32x4*)(H + o + 4) = h1;
                    ss += (h0[0] * h0[0] + h0[1] * h0[1]) + (h0[2] * h0[2] + h0[3] * h0[3]) + (h1[0] * h1[0] + h1[1] * h1[1]) + (h1[2] * h1[2] + h1[3] * h1[3]); }
                ss += __shfl_xor(ss, 16); ss += __shfl_xor(ss, 32);
                if (fq == 0) SS3[row * 32 + u.pn * 4 + wc] = ss;
                if (m & 1) asm volatile("" ::: "memory"); }
    }
};
struct EpiFf2N {
    static constexpr bool PERM = true, AFTER_DRAIN = true;
    const bf16_t* H2B; float* OUT; const float* SS2; float* XP; unsigned* CNT; const float* GF;
    __device__ __forceinline__ void fused(f32x4 (&acc)[2][2][4][2], const Unit& u, int wr, int wc, int fr, int fq, LAS unsigned char* lds, int wid, int lane) const {
        LAS float* P = (LAS float*)lds;
        LAS float* S = (LAS float*)(lds + 4096);
        const int row0 = u.pm * 256 + wr * 64 + fr, cl = u.pn * 256 + wc * 32 + 8 * fq;
#pragma unroll
        for (int ai = 0; ai < 2; ++ai)
#pragma unroll
            for (int m = 0; m < 4; ++m) { const size_t row = (size_t)(row0 + ai * 128 + m * 16);
                const f32x4 p0 = *(const f32x4*)(SS2 + row * 32 + fq * 8), p1 = *(const f32x4*)(SS2 + row * 32 + fq * 8 + 4);
                float t = ((p0[0] + p0[1]) + (p0[2] + p0[3])) + ((p1[0] + p1[1]) + (p1[2] + p1[3]));
                t += __shfl_xor(t, 16); t += __shfl_xor(t, 32);
                const float rs2 = 1.0f / (t * (1.0f / 2048.0f) + EPS); float ss = 0.f;
#pragma unroll
                for (int bj = 0; bj < 2; ++bj) { const size_t o = row * DM + cl + bj * 128;
                    f32x4 r0, r1; unpack8(*(const u32x4*)(H2B + o), r0, r1);
                    const f32x4 h0 = r0 + rs2 * acc[ai][bj][m][0], h1 = r1 + rs2 * acc[ai][bj][m][1];
                    acc[ai][bj][m][0] = h0; acc[ai][bj][m][1] = h1;
                    ss += (h0[0] * h0[0] + h0[1] * h0[1]) + (h0[2] * h0[2] + h0[3] * h0[3]) + (h1[0] * h1[0] + h1[1] * h1[1]) + (h1[2] * h1[2] + h1[3] * h1[3]); }
                ss += __shfl_xor(ss, 16); ss += __shfl_xor(ss, 32);
                if (fq == 0) P[(ai * 128 + wr * 64 + m * 16 + fr) * 4 + wc] = ss;
                if (m & 1) asm volatile("" ::: "memory"); }
        asm volatile("s_waitcnt lgkmcnt(0)" ::: "memory"); __builtin_amdgcn_s_barrier(); asm volatile("" ::: "memory");
        const int tid = wid * 64 + lane;
        if (tid < 256) { const f32x4 q = *(const LAS f32x4*)(P + tid * 4);
            __hip_atomic_store(XP + (size_t)(u.pm * 256 + tid) * 8 + u.pn, (q[0] + q[1]) + (q[2] + q[3]), __ATOMIC_RELAXED, __HIP_MEMORY_SCOPE_AGENT); }
        asm volatile("s_waitcnt vmcnt(0)" ::: "memory");
        if (wid < 4 && lane == 0) __hip_atomic_fetch_add(CNT + 64 * u.pm, 1u, __ATOMIC_RELAXED, __HIP_MEMORY_SCOPE_AGENT);
        if (wid == 0) {
            while ((unsigned)__builtin_amdgcn_readfirstlane(__hip_atomic_load(CNT + 64 * u.pm, __ATOMIC_RELAXED, __HIP_MEMORY_SCOPE_AGENT)) < 32u) __builtin_amdgcn_s_sleep(2);
            __builtin_amdgcn_fence(__ATOMIC_ACQUIRE, "agent");
        }
        asm volatile("s_waitcnt vmcnt(0) lgkmcnt(0)" ::: "memory"); __builtin_amdgcn_s_barrier(); asm volatile("" ::: "memory");
        if (tid < 256) { const float* xp = XP + (size_t)(u.pm * 256 + tid) * 8; float t = 0.f;
#pragma unroll
            for (int k = 0; k < 8; ++k) t += __hip_atomic_load(xp + k, __ATOMIC_RELAXED, __HIP_MEMORY_SCOPE_AGENT);
            S[tid] = rsqrtf(t * (1.0f / 2048.0f) + EPS); }
        asm volatile("s_waitcnt vmcnt(0) lgkmcnt(0)" ::: "memory"); __builtin_amdgcn_s_barrier(); asm volatile("" ::: "memory");
        f32x4 gv[2][2];
#pragma unroll
        for (int bj = 0; bj < 2; ++bj)
#pragma unroll
            for (int n = 0; n < 2; ++n) gv[bj][n] = *(const f32x4*)(GF + cl + bj * 128 + 4 * n);
#pragma unroll
        for (int ai = 0; ai < 2; ++ai)
#pragma unroll
            for (int m = 0; m < 4; ++m) { const int rl = ai * 128 + wr * 64 + m * 16 + fr; const float rstd = S[rl]; float* rowp = OUT + (size_t)(u.pm * 256 + rl) * DM + cl;
#pragma unroll
                for (int bj = 0; bj < 2; ++bj) { *(f32x4*)(rowp + bj * 128) = acc[ai][bj][m][0] * rstd * gv[bj][0]; *(f32x4*)(rowp + bj * 128 + 4) = acc[ai][bj][m][1] * rstd * gv[bj][1]; } }
    }
};
struct EpiCoGlu {
    static constexpr bool PERM = true, AFTER_DRAIN = false;
    EpiCo co; EpiGlu glu;
    __device__ __forceinline__ void operator()(const f32x4 (&acc)[2][2][4][2], const Unit& u, int wr, int wc, int fr, int fq) const {
        if (u.kind == 0) { co(acc, u, wr, wc, fr, fq); asm volatile("s_waitcnt vmcnt(0)" ::: "memory"); }
        else glu(acc, u, wr, wc, fr, fq);
    }
};
struct TripleOrder {
    pg8::StaticOrder S8;
    __device__ void init(int G_, int c_) { S8.init(T, DM, G_, c_); }
    __device__ bool next(int i, Unit& u) const { if (i > 2) return false; Unit t; if (!S8.next(0, t)) return false;
        u.pm = t.pm; if (i == 0) { u.pn = t.pn; u.kind = 0; } else { u.pn = 2 * t.pn + (i - 1); u.kind = 1; } return true; }
    __device__ __forceinline__ void a_ready(const Unit&) const {}
    __device__ __forceinline__ void done(const Unit&) const {}
};
struct Order1 : pg8::StaticOrder {
    pg8::StaticOrder S20;
    __device__ void init1(int G_, int c_) { init(T, NIN, G_, c_); S20.init(T, 20 * 256, G_, c_); }
    __device__ bool next(int i, Unit& u) const { const long L = (long)i * G + c;
        if (G == 256) {
            if (i >= 3) return false;
            if (L < 640) { (void)S20.next(i, u); if (u.pn >= 12) u.pn += 8; return true; }
            if (L < 652) { u.pm = 32; u.pn = (int)(L - 640); return true; }
            const int t = (int)(L - 652); u.pm = t >> 3; u.pn = 12 + (t & 7); return true;
        }
        if (L < nwg) return pg8::StaticOrder::next(i, u);
        if (L < nwg + 12) { u.pm = 32; u.pn = (int)(L - nwg); return true; } return false; }
};
struct DeferredOrder {
    int c;
    __device__ bool next(int i, Unit& u) const { if (i > 0) return false; const int t = 116 + c; u.pm = t >> 3; u.pn = 12 + (t & 7); return true; }
    __device__ __forceinline__ void a_ready(const Unit&) const {}
    __device__ __forceinline__ void done(const Unit&) const {}
};

__device__ __forceinline__ int srccol(int mode, int nb) {
    if (mode == 1) { if (nb < 1024 || nb >= 3072) return nb; const int q = (nb - 1024) >> 8, r = (nb - 1024) & 255; return r < 128 ? 1024 + 128 * q + r : 2048 + 128 * q + (r - 128); }
    if (mode == 2) { const int q = nb >> 8, r = nb & 255; return r < 128 ? 128 * q + r : 2048 + 128 * q + (r - 128); }
    return nb;
}
__device__ __forceinline__ void convert_tile(const float* __restrict__ W, bf16_t* __restrict__ Bt, int K, int N, int mode, int kt, int nt, LAS float* tile, int tid, const float* __restrict__ kscale) {
    const int w = tid >> 6, l = tid & 63, k0 = kt * 64, n0 = nt * 256;
    float v[32];
    int sc[4];
#pragma unroll
    for (int s = 0; s < 4; ++s) sc[s] = srccol(mode, n0 + 64 * s) + l;
#pragma unroll
    for (int i = 0; i < 32; ++i) v[i] = __builtin_nontemporal_load(W + (size_t)(k0 + w * 8 + (i >> 2)) * N + sc[i & 3]);
    if (kscale) {
#pragma unroll
        for (int i = 0; i < 32; i += 4) { const float g = kscale[k0 + w * 8 + (i >> 2)]; v[i] *= g; v[i + 1] *= g; v[i + 2] *= g; v[i + 3] *= g; }
    }
#pragma unroll
    for (int i = 0; i < 32; ++i) tile[(w * 8 + (i >> 2)) * 257 + 64 * (i & 3) + l] = v[i];
    __syncthreads();
#pragma unroll
    for (int p = 0; p < 4; ++p) { const int item = tid + 512 * p, nn = item >> 3, kc = (item & 7) * 8;
        f32x4 a, b;
#pragma unroll
        for (int j = 0; j < 4; ++j) { a[j] = tile[(kc + j) * 257 + nn]; b[j] = tile[(kc + 4 + j) * 257 + nn]; }
        *(u32x4*)(Bt + (((size_t)nt * (K / 64) + kt) * 256 + nn) * 64 + kc) = pack8(a, b); }
    __syncthreads();
}
__device__ __forceinline__ void dsincos(double x, double& s, double& c) {
    const double k = rint(x * 0.15915494309189535);
    double r = fma(-k, 6.283185307179586, x); r = fma(-k, 2.4492935982947064e-16, r);
    const double y = r * (1.0 / 1024.0), y2 = y * y;
    s = y * (1.0 - y2 / 6.0 * (1.0 - y2 / 20.0 * (1.0 - y2 / 42.0)));
    c = 1.0 - y2 / 2.0 * (1.0 - y2 / 12.0 * (1.0 - y2 / 30.0 * (1.0 - y2 / 56.0)));
#pragma unroll 1
    for (int i = 0; i < 10; ++i) { const double s2 = 2.0 * s * c, c2 = c * c - s * s; s = s2; c = c2; }
}
__device__ void s5_constants(const Params& p, int first, int stride) {
    unsigned char* ws = p.ws;
    for (int item = first; item < 4096; item += stride) {
        const int g = item >> 6, n = item & 63;
        const double dt = exp((double)p.in[6][g]);
        const double lr = (double)p.in[4][item], li = (double)p.in[5][item];
        const double mag = exp(lr * dt); double sn, cs; dsincos(li * dt, sn, cs);
        double ar = mag * cs, ai = mag * sn;
        const double nr = ar - 1.0, ni = ai, den = lr * lr + li * li;
        const double cr = (nr * lr + ni * li) / den, ci = (ni * lr - nr * li) / den;
        ((f32x2*)(ws + OFF_A1))[item] = (f32x2){(float)ar, (float)ai};
#pragma unroll 1
        for (int i = 0; i < 4; ++i) { const double r2 = ar * ar - ai * ai, i2 = 2.0 * ar * ai; ar = r2; ai = i2; }
        ((f32x2*)(ws + OFF_A16))[item] = (f32x2){(float)ar, (float)ai};
#pragma unroll 1
        for (int i = 0; i < 2; ++i) { const double r2 = ar * ar - ai * ai, i2 = 2.0 * ar * ai; ar = r2; ai = i2; }
        ((f32x2*)(ws + OFF_A64))[item] = (f32x2){(float)ar, (float)ai};
        bf16_t* bm = (bf16_t*)(ws + OFF_BMT) + ((size_t)g * 128 + 64 * (n >> 5) + (n & 31)) * 16;
        const float* bre = p.in[7] + (size_t)item * 16; const float* bim = p.in[8] + (size_t)item * 16;
#pragma unroll
        for (int h = 0; h < 16; h += 2) {
            const double b0r = bre[h], b0i = bim[h], b1r = bre[h + 1], b1i = bim[h + 1];
            *(unsigned*)(bm + h) = cvt_pk_bf16((float)(cr * b0r - ci * b0i), (float)(cr * b1r - ci * b1i));
            *(unsigned*)(bm + 32 * 16 + h) = cvt_pk_bf16((float)(cr * b0i + ci * b0r), (float)(cr * b1i + ci * b1r));
        }
        bf16_t* cm = (bf16_t*)(ws + OFF_CMT) + (size_t)g * 16 * 128 + 2 * n;
#pragma unroll
        for (int h = 0; h < 16; ++h) *(unsigned*)(cm + h * 128) = cvt_pk_bf16(p.in[9][((size_t)g * 16 + h) * 64 + n], -p.in[10][((size_t)g * 16 + h) * 64 + n]);
    }
}
__device__ void p0_prologue(const Params& p, LAS unsigned char* lds, int tid, int bid, int G) {
    unsigned char* ws = p.ws;
    {
        const int cnt[6] = {896, 256, 128, 256, 1024, 1024};
        (void)cnt;
        for (int t = bid; t < 3584; t += G) {
            const float* W; bf16_t* Bt; int K, N, mode, lt; const float* ksc = nullptr;
            if (t < 896) { W = p.in[3]; Bt = (bf16_t*)(ws + OFF_WIN); K = 2048; N = 7168; mode = 1; lt = t; }
            else if (t < 1152) { W = p.in[12]; Bt = (bf16_t*)(ws + OFF_WGLU); K = 1024; N = 4096; mode = 2; lt = t - 896; }
            else if (t < 1280) { W = p.in[17]; Bt = (bf16_t*)(ws + OFF_WCO); K = 1024; N = 2048; mode = 0; lt = t - 1152; }
            else if (t < 1536) { W = p.in[18]; Bt = (bf16_t*)(ws + OFF_WOUT); K = 2048; N = 2048; mode = 0; lt = t - 1280; }
            else if (t < 2560) { W = p.in[20]; Bt = (bf16_t*)(ws + OFF_WFF1); K = 2048; N = 8192; mode = 0; lt = t - 1536; ksc = p.in[19]; }
            else { W = p.in[21]; Bt = (bf16_t*)(ws + OFF_WFF2); K = 8192; N = 2048; mode = 0; lt = t - 2560; }
            const int nnt = N / 256;
            convert_tile(W, Bt, K, N, mode, lt / nnt, lt % nnt, (LAS float*)lds, tid, ksc);
        }
    }
    {
        const int lane = tid & 63, gw = bid * 8 + (tid >> 6);
        bf16_t* A0 = (bf16_t*)(ws + OFF_A0);
        const float* g = p.in[2];
        for (int r = gw; r < MP; r += G * 8) {
            const float* src = nullptr;
            if (r < T) src = p.in[0] + (size_t)r * DM; else if (r >= T + 48 && r < T + 64) src = p.in[1] + (size_t)(r - T - 48) * DM;
            if (src) {
                f32x4 v[8]; float ss = 0.f;
#pragma unroll
                for (int i = 0; i < 8; ++i) { v[i] = __builtin_nontemporal_load((const f32x4*)(src + 4 * (lane + 64 * i))); ss += (v[i][0] * v[i][0] + v[i][1] * v[i][1]) + (v[i][2] * v[i][2] + v[i][3] * v[i][3]); }
                ss = wave_sum(ss);
                const float rstd = rsqrtf(ss * (1.0f / 2048.0f) + EPS);
#pragma unroll
                for (int i = 0; i < 8; ++i) { const f32x4 gg = *(const f32x4*)(g + 4 * (lane + 64 * i)); const f32x4 o = v[i] * rstd * gg;
                    u32x2 w; w.x = cvt_pk_bf16(o[0], o[1]); w.y = cvt_pk_bf16(o[2], o[3]); *(u32x2*)(A0 + (size_t)r * DM + 4 * (lane + 64 * i)) = w; }
            } else {
#pragma unroll
                for (int i = 0; i < 8; ++i) *(u32x2*)(A0 + (size_t)r * DM + 4 * (lane + 64 * i)) = (u32x2){0u, 0u};
            }
        }
    }
    if (bid == 0 && tid < 32) ((unsigned*)(ws + OFF_CNT))[tid * 64] = 0u;
    if (tid >= 448 && tid < 464) s5_constants(p, bid * 16 + (tid - 448), G * 16);
    if (bid == 0 && tid == 32) *(unsigned*)(ws + OFF_QCTR) = 0u;
}
__device__ __forceinline__ int tile_time(int i) { return 16 * ((i & 7) >> 2) + 4 * (i >> 3) + (i & 3); }
#define CMUL_ADD(or_, oi_, ar_, ai_, sr_, si_, br_, bi_) do { const float _r = fmaf((ar_), (sr_), fmaf(-(ai_), (si_), (br_))); const float _i = fmaf((ar_), (si_), fmaf((ai_), (sr_), (bi_))); or_ = _r; oi_ = _i; } while (0)
constexpr int SROW = 272;
template <int MODE>
__device__ __forceinline__ void ssm_task(unsigned char* ws, const float* dskip, int g, int q_lo, int q_hi, LAS unsigned char* wl, int lane) {
    const int j = lane & 31, hf = lane >> 5;
    const bf16_t* U = (const bf16_t*)(ws + OFF_U);
    f32x2* E = (f32x2*)(ws + OFF_E);
    bf16x8 bfrag[4];
#pragma unroll
    for (int ct = 0; ct < 4; ++ct) bfrag[ct] = *(const bf16x8*)((const bf16_t*)(ws + OFF_BMT) + ((size_t)g * 128 + ct * 32 + j) * 16 + 8 * hf);
    const f32x2 aL = ((const f32x2*)(ws + OFF_A1))[g * 64 + j], aH = ((const f32x2*)(ws + OFF_A1))[g * 64 + 32 + j];
    const f32x2 bL = ((const f32x2*)(ws + OFF_A16))[g * 64 + j], bH = ((const f32x2*)(ws + OFF_A16))[g * 64 + 32 + j];
    const f32x2 cL = ((const f32x2*)(ws + OFF_A64))[g * 64 + j], cH = ((const f32x2*)(ws + OFF_A64))[g * 64 + 32 + j];
    bf16x8 cfrag[4]; f32x4 dsk = {0.f, 0.f, 0.f, 0.f};
    if (MODE == 1) {
#pragma unroll
        for (int ks = 0; ks < 4; ++ks) cfrag[ks] = *(const bf16x8*)((const bf16_t*)(ws + OFF_CMT) + ((size_t)g * 16 + (lane & 15)) * 128 + 32 * ks + 8 * (lane >> 4));
        dsk = *(const f32x4*)(dskip + 16 * g + 4 * (lane >> 4));
    }
    f32x2 sL = {0.f, 0.f}, sH = {0.f, 0.f};
#pragma unroll 1
    for (int q = q_lo; q < q_hi; ++q) {
        const int row0 = q * 64;
        if (MODE == 1) {
        if (q == q_lo) {
            const int b = q >> 5, c = q & 31;
            sL = E[((size_t)128 * 64 + g) * 64 + j]; sH = E[((size_t)128 * 64 + g) * 64 + 32 + j];
#pragma unroll 1
            for (int cp = 0; cp < c; cp += 4) { f32x2 eL[4], eH[4];
#pragma unroll
                for (int u4 = 0; u4 < 4; ++u4) { eL[u4] = E[((size_t)(b * 32 + cp + u4) * 64 + g) * 64 + j]; eH[u4] = E[((size_t)(b * 32 + cp + u4) * 64 + g) * 64 + 32 + j]; }
#pragma unroll
                for (int u4 = 0; u4 < 4; ++u4) { CMUL_ADD(sL.x, sL.y, cL.x, cL.y, sL.x, sL.y, eL[u4].x, eL[u4].y); CMUL_ADD(sH.x, sH.y, cH.x, cH.y, sH.x, sH.y, eH[u4].x, eH[u4].y); } }
        }
        }
        f32x16 acc[2][4];
#pragma unroll
        for (int mt = 0; mt < 2; ++mt) {
            const bf16x8 af = *(const bf16x8*)(U + (size_t)(row0 + 32 * mt + tile_time(j)) * DS + 16 * g + 8 * hf);
#pragma unroll
            for (int ct = 0; ct < 4; ++ct) { f32x16 z;
#pragma unroll
                for (int r = 0; r < 16; ++r) z[r] = 0.f;
                acc[mt][ct] = __builtin_amdgcn_mfma_f32_32x32x16_bf16(af, bfrag[ct], z, 0, 0, 0); }
            asm volatile("" :: "v"(af), "v"(acc[mt][0]), "v"(acc[mt][1]), "v"(acc[mt][2]), "v"(acc[mt][3]));
        }
        float eLr[2], eLi[2], eHr[2], eHi[2];
#pragma unroll
        for (int mt = 0; mt < 2; ++mt) { float sr = 0.f, si = 0.f, tr = 0.f, ti = 0.f;
#pragma unroll
            for (int r = 0; r < 16; ++r) { CMUL_ADD(sr, si, aL.x, aL.y, sr, si, acc[mt][0][r], acc[mt][1][r]); CMUL_ADD(tr, ti, aH.x, aH.y, tr, ti, acc[mt][2][r], acc[mt][3][r]); }
            eLr[mt] = sr; eLi[mt] = si; eHr[mt] = tr; eHi[mt] = ti; }
        float pLr[2], pLi[2], pHr[2], pHi[2];
#pragma unroll
        for (int mt = 0; mt < 2; ++mt) { pLr[mt] = __shfl_xor(eLr[mt], 32); pLi[mt] = __shfl_xor(eLi[mt], 32); pHr[mt] = __shfl_xor(eHr[mt], 32); pHi[mt] = __shfl_xor(eHi[mt], 32); }
        if (MODE == 0) {
            float f0r, f0i, f1r, f1i, g0r, g0i, g1r, g1i;
            CMUL_ADD(f0r, f0i, bL.x, bL.y, pLr[0], pLi[0], eLr[0], eLi[0]); CMUL_ADD(f1r, f1i, bL.x, bL.y, pLr[1], pLi[1], eLr[1], eLi[1]);
            CMUL_ADD(g0r, g0i, bH.x, bH.y, pHr[0], pHi[0], eHr[0], eHi[0]); CMUL_ADD(g1r, g1i, bH.x, bH.y, pHr[1], pHi[1], eHr[1], eHi[1]);
            const float b2Lr = bL.x * bL.x - bL.y * bL.y, b2Li = 2.f * bL.x * bL.y, b2Hr = bH.x * bH.x - bH.y * bH.y, b2Hi = 2.f * bH.x * bH.y;
            float ELr, ELi, EHr, EHi;
            CMUL_ADD(ELr, ELi, b2Lr, b2Li, f0r, f0i, f1r, f1i); CMUL_ADD(EHr, EHi, b2Hr, b2Hi, g0r, g0i, g1r, g1i);
            if (hf == 1) { E[((size_t)q * 64 + g) * 64 + j] = (f32x2){ELr, ELi}; E[((size_t)q * 64 + g) * 64 + 32 + j] = (f32x2){EHr, EHi}; }
        } else {
            const float e0Lr = hf ? pLr[0] : eLr[0], e0Li = hf ? pLi[0] : eLi[0], e1Lr = hf ? eLr[0] : pLr[0], e1Li = hf ? eLi[0] : pLi[0], e2Lr = hf ? pLr[1] : eLr[1], e2Li = hf ? pLi[1] : eLi[1];
            const float e0Hr = hf ? pHr[0] : eHr[0], e0Hi = hf ? pHi[0] : eHi[0], e1Hr = hf ? eHr[0] : pHr[0], e1Hi = hf ? eHi[0] : pHi[0], e2Hr = hf ? pHr[1] : eHr[1], e2Hi = hf ? pHi[1] : eHi[1];
            float i1Lr, i1Li, i2Lr, i2Li, i3Lr, i3Li, i1Hr, i1Hi, i2Hr, i2Hi, i3Hr, i3Hi;
            CMUL_ADD(i1Lr, i1Li, bL.x, bL.y, sL.x, sL.y, e0Lr, e0Li); CMUL_ADD(i2Lr, i2Li, bL.x, bL.y, i1Lr, i1Li, e1Lr, e1Li); CMUL_ADD(i3Lr, i3Li, bL.x, bL.y, i2Lr, i2Li, e2Lr, e2Li);
            CMUL_ADD(i1Hr, i1Hi, bH.x, bH.y, sH.x, sH.y, e0Hr, e0Hi); CMUL_ADD(i2Hr, i2Hi, bH.x, bH.y, i1Hr, i1Hi, e1Hr, e1Hi); CMUL_ADD(i3Hr, i3Hi, bH.x, bH.y, i2Hr, i2Hi, e2Hr, e2Hi);
            float inLr[2], inLi[2], inHr[2], inHi[2];
            inLr[0] = hf ? i1Lr : sL.x; inLi[0] = hf ? i1Li : sL.y; inLr[1] = hf ? i3Lr : i2Lr; inLi[1] = hf ? i3Li : i2Li;
            inHr[0] = hf ? i1Hr : sH.x; inHi[0] = hf ? i1Hi : sH.y; inHr[1] = hf ? i3Hr : i2Hr; inHi[1] = hf ? i3Hi : i2Hi;
#pragma unroll
            for (int mt = 0; mt < 2; ++mt) {
                float sr = inLr[mt], si = inLi[mt], tr = inHr[mt], ti = inHi[mt];
#pragma unroll
                for (int r = 0; r < 16; ++r) { CMUL_ADD(sr, si, aL.x, aL.y, sr, si, acc[mt][0][r], acc[mt][1][r]); CMUL_ADD(tr, ti, aH.x, aH.y, tr, ti, acc[mt][2][r], acc[mt][3][r]);
                    *(LAS unsigned*)(wl + (16 * hf + r) * SROW + 4 * j) = cvt_pk_bf16(sr, si);
                    *(LAS unsigned*)(wl + (16 * hf + r) * SROW + 4 * (32 + j)) = cvt_pk_bf16(tr, ti); }
                if (mt == 1) {
                    const float oLr = __shfl_xor(sr, 32), oLi = __shfl_xor(si, 32), oHr = __shfl_xor(tr, 32), oHi = __shfl_xor(ti, 32);
                    sL.x = hf ? sr : oLr; sL.y = hf ? si : oLi; sH.x = hf ? tr : oHr; sH.y = hf ? ti : oHi; }
                asm volatile("s_waitcnt lgkmcnt(0)" ::: "memory");
#pragma unroll
                for (int th = 0; th < 2; ++th) {
                    f32x4 y = {0.f, 0.f, 0.f, 0.f};
                    bf16x8 sf[4];
#pragma unroll
                    for (int ks = 0; ks < 4; ++ks) sf[ks] = *(const LAS bf16x8*)(wl + (16 * th + (lane & 15)) * SROW + 64 * ks + 16 * (lane >> 4));
#pragma unroll
                    for (int ks = 0; ks < 4; ++ks) y = __builtin_amdgcn_mfma_f32_16x16x32_bf16(cfrag[ks], sf[ks], y, 0, 0, 0);
                    asm volatile("" :: "v"(sf[0]), "v"(sf[1]), "v"(sf[2]), "v"(sf[3]), "v"(y));
                    const size_t row = (size_t)(row0 + 32 * mt + 16 * th + (lane & 15)); const int col = 16 * g + 4 * (lane >> 4);
                    const u32x2 uu = *(const u32x2*)(U + row * DS + col);
                    f32x4 v; v[0] = fmaf(dsk[0], bflo(uu.x), y[0]); v[1] = fmaf(dsk[1], bfhi(uu.x), y[1]); v[2] = fmaf(dsk[2], bflo(uu.y), y[2]); v[3] = fmaf(dsk[3], bfhi(uu.y), y[3]);
#pragma unroll
                    for (int r = 0; r < 4; ++r) { const float x = v[r]; v[r] = x * sigm(1.5957691216f * (x + 0.044715f * x * x * x)); }
                    u32x2 o; o.x = cvt_pk_bf16(v[0], v[1]); o.y = cvt_pk_bf16(v[2], v[3]);
                    *(u32x2*)((bf16_t*)(ws + OFF_Z) + row * DS + col) = o;
                }
                asm volatile("s_waitcnt lgkmcnt(0)" ::: "memory");
            }
        }
    }
}

__device__ __forceinline__ void conv_tile(const Params& p, int ti, LAS float* ol, int tid) {
    unsigned char* ws = p.ws;
    const bf16_t* Cg = (const bf16_t*)(ws + OFF_CG);
    const int b = ti >> 7, l0 = (ti & 127) * 16, ch = 2 * tid;
    unsigned d[46];
#pragma unroll
    for (int jj = 0; jj < 46; ++jj) { const int o = l0 + jj - 30; const size_t row = (o >= 0) ? (size_t)(b * 2048 + o) : (size_t)(T + 64 + o); d[jj] = *(const unsigned*)(Cg + row * DS + ch); }
    f32x2 w[31];
#pragma unroll
    for (int j = 0; j < 31; ++j) w[j] = *(const f32x2*)(p.in[13] + j * DS + ch);
    const f32x2 bias = *(const f32x2*)(p.in[14] + ch);
#pragma unroll
    for (int tok = 0; tok < 16; ++tok) { float a0 = bias.x, a1 = bias.y;
#pragma unroll
        for (int j = 0; j < 31; ++j) { const unsigned x = d[tok + j]; a0 = fmaf(w[j].x, bflo(x), a0); a1 = fmaf(w[j].y, bfhi(x), a1); }
        *(LAS f32x2*)(ol + tok * DS + ch) = (f32x2){a0, a1}; }
    __syncthreads();
    const int wv = tid >> 6, lane = tid & 63;
#pragma unroll
    for (int tt = 0; tt < 2; ++tt) { const int tok = 2 * wv + tt; const size_t row = (size_t)(b * 2048 + l0 + tok);
        f32x4 v[4]; float s = 0.f;
#pragma unroll
        for (int i = 0; i < 4; ++i) { v[i] = *(const LAS f32x4*)(ol + tok * DS + 4 * (lane + 64 * i)); s += (v[i][0] + v[i][1]) + (v[i][2] + v[i][3]); }
        const float mean = wave_sum(s) * (1.0f / 1024.0f); float q = 0.f;
#pragma unroll
        for (int i = 0; i < 4; ++i) { v[i] = v[i] - mean; q += (v[i][0] * v[i][0] + v[i][1] * v[i][1]) + (v[i][2] * v[i][2] + v[i][3] * v[i][3]); }
        const float rstd = rsqrtf(wave_sum(q) * (1.0f / 1024.0f) + EPS);
#pragma unroll
        for (int i = 0; i < 4; ++i) { const int col = 4 * (lane + 64 * i); const f32x4 gg = *(const f32x4*)(p.in[15] + col), bb = *(const f32x4*)(p.in[16] + col);
            f32x4 y = v[i] * rstd * gg + bb;
#pragma unroll
            for (int r = 0; r < 4; ++r) y[r] = y[r] * sigm(y[r]);
            u32x2 o; o.x = cvt_pk_bf16(y[0], y[1]); o.y = cvt_pk_bf16(y[2], y[3]);
            *(u32x2*)((bf16_t*)(ws + OFF_CS) + row * DS + col) = o; }
    }
    __syncthreads();
}

#define XB_TMO      128
#define XB_XCNT(j)  (256  + 64 * (j))
#define XB_XSUB(j)  (1280 + 64 * (j))
#define XB_XGEN(j)  (2304 + 64 * (j))
#define XB_TOP      3328
#define XB_TOPGEN   3392
#define XCD_BAR_WORDS 3456
#define XB_SPIN_CAP (1u << 18)
__device__ __forceinline__ unsigned xb_ld(unsigned* p)              { return __hip_atomic_load(p, __ATOMIC_RELAXED, __HIP_MEMORY_SCOPE_AGENT); }
__device__ __forceinline__ unsigned xb_add(unsigned* p, unsigned v) { return __hip_atomic_fetch_add(p, v, __ATOMIC_RELAXED, __HIP_MEMORY_SCOPE_AGENT); }
__device__ __forceinline__ unsigned xb_xcc_id() { return (unsigned)__builtin_amdgcn_s_getreg((3 << 11) | 20) & 0xFu; }
#define XB_SPIN(cond, bar) do { unsigned _sp = 0; while (cond) { __builtin_amdgcn_s_sleep(1); \
    if ((++_sp & 255u) == 0u) { if (xb_ld(&(bar)[XB_TMO])) break; if (_sp > XB_SPIN_CAP) { atomicAdd(&(bar)[XB_TMO], 1u); break; } } } } while (0)

struct XcdBarrier {
    unsigned* bar; unsigned x;
    volatile LAS unsigned* st;
};

__device__ __forceinline__ XcdBarrier xcd_barrier_post(unsigned* bar, volatile LAS unsigned* st) {
    XcdBarrier b; b.bar = bar; b.x = xb_xcc_id(); b.st = st;
    if (threadIdx.x == 0) (void)xb_add(&bar[XB_XCNT(b.x)], 1u);
    return b;
}
__device__ __forceinline__ void xcd_barrier_complete(unsigned* bar, unsigned x, unsigned& nloc, unsigned& nx) {
    const unsigned G = gridDim.x * gridDim.y * gridDim.z;
    unsigned sum, cnt, mine, sp = 0u;
    for (;;) {
        sum = 0u; cnt = 0u; mine = 0u;
#pragma unroll
        for (unsigned j = 0; j < 16; ++j) { const unsigned c = xb_ld(&bar[XB_XCNT(j)]); sum += c; cnt += (c > 0u) ? 1u : 0u; mine = (j == x) ? c : mine; }
        if (sum == G) break;
        __builtin_amdgcn_s_sleep(1);
        if ((++sp & 255u) == 0u) { if (xb_ld(&bar[XB_TMO])) break; if (sp > XB_SPIN_CAP) { atomicAdd(&bar[XB_TMO], 1u); break; } }
    }
    nloc = mine > 0u ? mine : 1u; nx = cnt > 0u ? cnt : 1u;
}

__device__ __forceinline__ void xcd_barrier(const XcdBarrier& b) {
    asm volatile("s_waitcnt vmcnt(0)" ::: "memory");
    __syncthreads();
    if (threadIdx.x == 0) {
        unsigned* bar = b.bar;
        __builtin_amdgcn_s_waitcnt(0);
        unsigned nloc = b.st[0], nx = b.st[1];
        if (nloc == 0u) { xcd_barrier_complete(bar, b.x, nloc, nx); b.st[0] = nloc; b.st[1] = nx; }
        const unsigned old = xb_add(&bar[XB_XSUB(b.x)], 1u);
        const unsigned gen = old / nloc;
        if (old + 1u == (gen + 1u) * nloc) {
            __builtin_amdgcn_fence(__ATOMIC_RELEASE, "agent");
            asm volatile("s_waitcnt vmcnt(0)" ::: "memory");
            const unsigned og = xb_add(&bar[XB_TOP], 1u);
            const unsigned tg = og / nx;
            if (og + 1u == (tg + 1u) * nx) xb_add(&bar[XB_TOPGEN], 1u);
            else XB_SPIN(xb_ld(&bar[XB_TOPGEN]) == tg, bar);
            __builtin_amdgcn_fence(__ATOMIC_ACQUIRE, "agent");
            xb_add(&bar[XB_XGEN(b.x)], 1u);
            asm volatile("s_waitcnt vmcnt(0)" ::: "memory");
        } else {
            XB_SPIN(xb_ld(&bar[XB_XGEN(b.x)]) == gen, bar);
            __builtin_amdgcn_fence(__ATOMIC_ACQUIRE, "agent");
            asm volatile("s_waitcnt vmcnt(0)" ::: "memory");
        }
    }
    __syncthreads();
}

__global__ void __launch_bounds__(512, 2) fwd_kernel(Params p) {
    extern __shared__ __attribute__((aligned(16))) unsigned char lds_raw[];
    LAS unsigned char* lds = (LAS unsigned char*)lds_raw;
    const int tid = threadIdx.x, bid = blockIdx.x, G = gridDim.x, wave = __builtin_amdgcn_readfirstlane(tid >> 6), lane = tid & 63;
    unsigned char* ws = p.ws;
    const int lo = p.ph_lo, hi = p.ph_hi;
#define IN(k) (lo <= (k) && (k) < hi)
    if (hi > 1000) cg::this_grid().sync();
    volatile LAS unsigned* xst = (volatile LAS unsigned*)(lds + LDS_MAIN);
    if (tid == 0) { xst[0] = 0u; xst[1] = 0u; }
    __syncthreads();
    const XcdBarrier xbar = xcd_barrier_post((unsigned*)(ws + OFF_BAR), xst);
#define SEAM(k) do { if (IN(k) && IN((k) + 1)) xcd_barrier(xbar); } while (0)
    if (IN(0)) p0_prologue(p, lds, tid, bid, G);
    SEAM(0);
    if (IN(1)) {
        pg8::Gemm g{(const bf16_t*)(ws + OFF_A0), (const bf16_t*)(ws + OFF_WIN), T, NIN, DM}; Order1 S; S.init1(G, bid);
        Epi1 E{(bf16_t*)(ws + OFF_U), (bf16_t*)(ws + OFF_CG), (bf16_t*)(ws + OFF_SG)};
        pg8::gemm_phase<Epi1, Order1>(lds, g, S, E);
    }
    SEAM(1);
    if (IN(2)) {
        if (G == 256) {
            if (bid < 140) {
                pg8::Gemm g{(const bf16_t*)(ws + OFF_A0), (const bf16_t*)(ws + OFF_WIN), T, NIN, DM}; DeferredOrder S{bid};
                Epi1 E{(bf16_t*)(ws + OFF_U), (bf16_t*)(ws + OFF_CG), (bf16_t*)(ws + OFF_SG)};
                pg8::gemm_phase<Epi1, DeferredOrder>(lds, g, S, E);
            }
            volatile LAS unsigned* qw = (volatile LAS unsigned*)(lds + LDS_MAIN + 8);
            for (;;) {
                __syncthreads();
                if (tid == 0) *qw = __hip_atomic_fetch_add((unsigned*)(ws + OFF_QCTR), 1u, __ATOMIC_RELAXED, __HIP_MEMORY_SCOPE_AGENT);
                __syncthreads();
                const int item = (int)*qw;
                if (item >= 264 + 512) break;
                if (item < 264) { const int go = item & 7, cs = item >> 3; const int qh = (cs * 4 + 4 < 129) ? cs * 4 + 4 : 129;
                    ssm_task<0>(ws, p.in[11], go * 8 + wave, cs * 4, qh, lds + wave * (32 * SROW), lane); }
                else conv_tile(p, item - 264, (LAS float*)lds, tid);
            }
        } else {
            for (int task = bid; task < 33 * 8; task += G) { const int go = task & 7, cs = task >> 3; const int qh = (cs * 4 + 4 < 129) ? cs * 4 + 4 : 129;
                ssm_task<0>(ws, p.in[11], go * 8 + wave, cs * 4, qh, lds + wave * (32 * SROW), lane); }
            __syncthreads();
            for (int ti = bid; ti < 512; ti += G) conv_tile(p, ti, (LAS float*)lds, tid);
        }
    }
    SEAM(2);
    if (IN(3)) {
        for (int task = bid; task < 32 * 8; task += G) { const int go = task & 7, cs = task >> 3;
            ssm_task<1>(ws, p.in[11], go * 8 + wave, cs * 4, cs * 4 + 4, lds + wave * (32 * SROW), lane); }
        __syncthreads();
        if (G != 256) {
            pg8::Gemm g{(const bf16_t*)(ws + OFF_CS), (const bf16_t*)(ws + OFF_WCO), T, DM, DS}; pg8::StaticOrder S; S.init(T, DM, G, bid);
            EpiCo E{(const bf16_t*)(ws + OFF_SG), (bf16_t*)(ws + OFF_TB)};
            pg8::gemm_phase<EpiCo, pg8::StaticOrder>(lds, g, S, E);
        }
    }
    SEAM(3);
    if (IN(4)) {
        if (G == 256) {
            pg8::Gemm g{(const bf16_t*)(ws + OFF_CS), (const bf16_t*)(ws + OFF_WCO), T, DM, DS, (const bf16_t*)(ws + OFF_Z), (const bf16_t*)(ws + OFF_WGLU)};
            TripleOrder S; S.init(G, bid);
            EpiCoGlu E{EpiCo{(const bf16_t*)(ws + OFF_SG), (bf16_t*)(ws + OFF_TB)}, EpiGlu{(const bf16_t*)(ws + OFF_SG), (const bf16_t*)(ws + OFF_TB), (bf16_t*)(ws + OFF_MG)}};
            pg8::gemm_phase<EpiCoGlu, TripleOrder, true>(lds, g, S, E);
        } else {
            pg8::Gemm g{(const bf16_t*)(ws + OFF_Z), (const bf16_t*)(ws + OFF_WGLU), T, 4096, DS}; pg8::StaticOrder S; S.init(T, 4096, G, bid);
            EpiGlu E{(const bf16_t*)(ws + OFF_SG), (const bf16_t*)(ws + OFF_TB), (bf16_t*)(ws + OFF_MG)};
            pg8::gemm_phase<EpiGlu, pg8::StaticOrder>(lds, g, S, E);
        }
    }
    SEAM(4);
    if (IN(5)) {
        pg8::Gemm g{(const bf16_t*)(ws + OFF_MG), (const bf16_t*)(ws + OFF_WOUT), T, DM, DM}; pg8::StaticOrder S; S.init(T, DM, G, bid);
        EpiOut E{p.in[0], (bf16_t*)(ws + OFF_HG), (float*)(ws + OFF_SS2)};
        pg8::gemm_phase<EpiOut, pg8::StaticOrder>(lds, g, S, E);
    }
    SEAM(5);
    if (IN(6)) {
        pg8::Gemm g{(const bf16_t*)(ws + OFF_HG), (const bf16_t*)(ws + OFF_WFF1), T, DFF, DM}; pg8::StaticOrder S; S.init(T, DFF, G, bid);
        EpiFf1 E{(bf16_t*)(ws + OFF_ACT)};
        pg8::gemm_phase<EpiFf1, pg8::StaticOrder>(lds, g, S, E);
    }
    SEAM(6);
    if (IN(7)) {
        pg8::Gemm g{(const bf16_t*)(ws + OFF_ACT), (const bf16_t*)(ws + OFF_WFF2), T, DM, DFF}; pg8::StaticOrder S; S.init(T, DM, G, bid);
        if (G == 256) {
            EpiFf2N E{(const bf16_t*)(ws + OFF_HG), p.out, (const float*)(ws + OFF_SS2), (float*)(ws + OFF_SS3), (unsigned*)(ws + OFF_CNT), p.in[22]};
            pg8::gemm_phase<EpiFf2N, pg8::StaticOrder, false, true>(lds, g, S, E);
        } else {
            EpiFf2 E{(const bf16_t*)(ws + OFF_HG), p.out, (const float*)(ws + OFF_SS2), (float*)(ws + OFF_SS3)};
            pg8::gemm_phase<EpiFf2, pg8::StaticOrder, false, true>(lds, g, S, E);
        }
    }
    if (G != 256) SEAM(7);
    if (IN(8) && G != 256) {
        const float* SS3 = (const float*)(ws + OFF_SS3); const float* gf = p.in[22];
        for (int row = bid * 8 + wave; row < T; row += G * 8) {
            float t = SS3[(size_t)row * 32 + (lane & 31)];
            t += __shfl_xor(t, 16); t += __shfl_xor(t, 8); t += __shfl_xor(t, 4); t += __shfl_xor(t, 2); t += __shfl_xor(t, 1);
            const float rstd = rsqrtf(t * (1.0f / 2048.0f) + EPS);
            float* o = p.out + (size_t)row * DM;
#pragma unroll
            for (int i = 0; i < 8; ++i) { const int col = 4 * (lane + 64 * i); const f32x4 v = *(const f32x4*)(o + col), gg = *(const f32x4*)(gf + col); *(f32x4*)(o + col) = v * rstd * gg; }
        }
    }
#undef IN
#undef SEAM
}

extern "C" void kernel_launch(void* const* d_in, const int* in_sizes, int n_in, void* d_out, int out_size, void* d_ws, size_t ws_size, hipStream_t stream) {
    static int grid = 0;
    if (grid == 0) {
        if (n_in != 23 || out_size != T * DM || ws_size < WS_END) { fprintf(stderr, "kernel_launch: unexpected shapes (n_in %d out %d ws %zu need %zu)\n", n_in, out_size, ws_size, (size_t)WS_END); grid = -1; return; }
        int dev = 0, cus = 0, per_cu = 0;
        (void)hipGetDevice(&dev); (void)hipDeviceGetAttribute(&cus, hipDeviceAttributeMultiprocessorCount, dev);
        if (hipFuncSetAttribute((const void*)fwd_kernel, hipFuncAttributeMaxDynamicSharedMemorySize, LDS_BYTES) != hipSuccess) { fprintf(stderr, "kernel_launch: hipFuncSetAttribute failed\n"); grid = -1; return; }
        if (hipOccupancyMaxActiveBlocksPerMultiprocessor(&per_cu, (const void*)fwd_kernel, 512, LDS_BYTES) != hipSuccess || per_cu < 1) { fprintf(stderr, "kernel_launch: occupancy query says %d blocks/CU\n", per_cu); (void)hipGetLastError(); per_cu = 1; }
        grid = cus;
        if (grid > cus * per_cu) grid = cus * per_cu;
    }
    if (grid < 0) return;
    Params p{};
    for (int i = 0; i < 23; ++i) p.in[i] = (const float*)d_in[i];
    p.out = (float*)d_out; p.ws = (unsigned char*)d_ws;
    p.ph_lo = 0; p.ph_hi = 9;
    (void)hipMemsetAsync((unsigned char*)d_ws + OFF_BAR, 0, XCD_BAR_WORDS * 4, stream);
    void* args[] = {&p};
    hipError_t e = hipLaunchCooperativeKernel((const void*)fwd_kernel, dim3(grid), dim3(512), args, LDS_BYTES, stream);
    if (e != hipSuccess) fprintf(stderr, "cooperative launch failed: %s (grid %d)\n", hipGetErrorString(e), grid);
}
```
